# Optimizing an MI355X kernel written in HIP

```python
import math
import jax, jax.numpy as jnp
from jax import lax
import numpy as np

D_MODEL = 1024
BATCH = 8
SEQ = 4096
DEPTH = 2

HEAD_DIM = 64
HY_WIDTH = D_MODEL // 2
HY_ORDER = 2
HY_FILT_HIDDEN = 64
HY_POS_BANDS = 16
HY_EMB = 1 + 2 * HY_POS_BANDS
HY_FAST_DECAY_PCT = 0.3
HY_SLOW_DECAY_PCT = 1.5
HY_DECAY_TARGET = 1e-2
WINDOWS = (128, 512, 2048)
DILATIONS = (1, 4, 16)
N_GROUPS = 3
HEADS_PER_GROUP = 4
N_ATT_HEADS = N_GROUPS * HEADS_PER_GROUP
ATT_WIDTH = N_ATT_HEADS * HEAD_DIM
ATT_OUT = HEADS_PER_GROUP * HEAD_DIM
REL_BUCKETS = 32
REL_MAX_DISTANCE = 1024
D_FF = (8 * D_MODEL // 3) // 128 * 128
N_BRANCH = 2
IN_WIDTH = 3 * HY_WIDTH + 3 * ATT_WIDTH
EPS = 1e-6
NEG = -1e30

kernel_name = "hybrid_hyena_dilated_attn_macaron"


def rms_norm(x, g):
    xf = x.astype(jnp.float32)
    y = xf * lax.rsqrt(jnp.mean(xf * xf, axis=-1, keepdims=True) + EPS)
    return (y * g.astype(jnp.float32)).astype(x.dtype)


def swiglu(h, w_gate, w_up, w_down):
    return (jax.nn.silu(h @ w_gate) * (h @ w_up)) @ w_down


def short_conv3(u, w, b):
    up = jnp.pad(u, ((0, 0), (1, 1), (0, 0)))
    return up[:, :-2] * w[0] + up[:, 1:-1] * w[1] + up[:, 2:] * w[2] + b


def hyena_filters(L, w1, b1, w2, b2, w3):
    f32 = jnp.float32
    t = jnp.linspace(0.0, 1.0, L, dtype=f32)[:, None]
    w = (2.0 * math.pi / L) * jnp.arange(L, dtype=f32)[:, None]
    f = jnp.linspace(1e-4, HY_POS_BANDS - 1, HY_POS_BANDS, dtype=f32)[None]
    z = jnp.concatenate([t, jnp.cos(f * w), -jnp.sin(f * w)], axis=-1)
    hid = jnp.sin(z @ w1.astype(f32) + b1.astype(f32))
    hid = jnp.sin(hid @ w2.astype(f32) + b2.astype(f32))
    k = (hid @ w3.astype(f32)).reshape(L, HY_ORDER, 2, HY_WIDTH)
    max_decay = math.log(HY_DECAY_TARGET) / HY_FAST_DECAY_PCT
    min_decay = math.log(HY_DECAY_TARGET) / HY_SLOW_DECAY_PCT
    deltas = jnp.abs(jnp.linspace(min_decay, max_decay, HY_WIDTH, dtype=f32))
    k = k * jnp.exp(-t * deltas[None])[:, None, None, :]
    full = jnp.concatenate([k[:, :, 0], jnp.zeros((1, HY_ORDER, HY_WIDTH), f32), k[:0:-1, :, 1]], axis=0)
    full = full * lax.rsqrt(jnp.sum(full * full, axis=0, keepdims=True) + EPS)
    return jnp.fft.rfft(full, axis=0)


def long_conv(u, kf):
    L = u.shape[1]
    U = jnp.fft.rfft(u.astype(jnp.float32), n=2 * L, axis=1)
    return jnp.fft.irfft(U * kf[None], n=2 * L, axis=1)[:, :L]


def t5_bucket(rel):
    half = REL_BUCKETS // 2
    exact = half // 2
    ret = jnp.where(rel > 0, half, 0)
    n = jnp.abs(rel)
    nf = jnp.maximum(n, 1).astype(jnp.float32)
    large = exact + (jnp.log(nf / exact) / math.log(REL_MAX_DISTANCE / exact) * (half - exact)).astype(jnp.int32)
    large = jnp.minimum(large, half - 1)
    return ret + jnp.where(n < exact, n, large)


def dilated_group_attn(q, k, v, bias_table, dilation, n_side):
    b, s, h, dh = q.shape
    m = s // dilation
    nb = -(-m // n_side)
    mp = nb * n_side
    bd = b * dilation

    def by_residue(t):
        return t.reshape(b, m, dilation, h, dh).transpose(0, 2, 1, 3, 4).reshape(bd, m, h, dh)

    def key_windows(t):
        tp = jnp.pad(t, ((0, 0), (n_side, n_side + mp - m), (0, 0), (0, 0))).reshape(bd, nb + 2, n_side, h, dh)
        return jnp.concatenate([tp[:, :-2], tp[:, 1:-1], tp[:, 2:]], axis=2)

    qb = jnp.pad(by_residue(q), ((0, 0), (0, mp - m), (0, 0), (0, 0))).reshape(bd, nb, n_side, h, dh)
    kw = key_windows(by_residue(k))
    vw = key_windows(by_residue(v))
    scores = jnp.einsum('bnqhd,bnkhd->bhnqk', qb.astype(jnp.float32), kw.astype(jnp.float32)) * (HEAD_DIM ** -0.5)
    qi = jnp.arange(n_side)
    ki = jnp.arange(3 * n_side)
    rel = ki[None, :] - n_side - qi[:, None]
    key_pos = jnp.arange(nb)[:, None] * n_side + ki[None, :] - n_side
    valid = (jnp.abs(rel) <= n_side)[None] & ((key_pos >= 0) & (key_pos < m))[:, None, :]
    bias = bias_table[t5_bucket(rel * dilation)].astype(jnp.float32).transpose(2, 0, 1)
    scores = jnp.where(valid, scores + bias[:, None], NEG)
    mx = jnp.max(scores, axis=-1, keepdims=True)
    p = jnp.exp(scores - mx)
    denom = jnp.sum(p, axis=-1, keepdims=True)
    out = jnp.einsum('bhnqk,bnkhd->bnqhd', p, vw.astype(jnp.float32)) / denom.transpose(0, 2, 3, 1, 4)
    lse = (mx + jnp.log(denom))[..., 0].transpose(0, 2, 3, 1)
    out = out.reshape(bd, mp, h, dh)[:, :m].reshape(b, dilation, m, h, dh).transpose(0, 2, 1, 3, 4).reshape(b, s, h, dh)
    lse = lse.reshape(bd, mp, h)[:, :m].reshape(b, dilation, m, h).transpose(0, 2, 1, 3).reshape(b, s, h)
    return out, lse


def hybrid_mixer(h, rel_bias, w_in, w_gate, b_gate, hy_conv_w, hy_conv_b, hy_filt_w1, hy_filt_b1,
                 hy_filt_w2, hy_filt_b2, hy_filt_w3, hy_skip, q_norm, k_norm, w_hy_proj, w_at_proj, w_out):
    b, s, _ = h.shape
    proj = h @ w_in
    hy = short_conv3(proj[..., :3 * HY_WIDTH], hy_conv_w, hy_conv_b)
    z, x1, x2 = jnp.split(hy, 3, axis=-1)
    kf = hyena_filters(s, hy_filt_w1, hy_filt_b1, hy_filt_w2, hy_filt_b2, hy_filt_w3)
    for o, gate in enumerate((x1, x2)):
        z = gate * (long_conv(z, kf[:, o]).astype(z.dtype) + hy_skip[o] * z)
    y_hy = z
    qkv = proj[..., 3 * HY_WIDTH:].reshape(b, s, 3, N_GROUPS, HEADS_PER_GROUP, HEAD_DIM)
    q = rms_norm(qkv[:, :, 0], q_norm)
    k = rms_norm(qkv[:, :, 1], k_norm)
    v = qkv[:, :, 2]
    outs, lses = [], []
    for g in range(N_GROUPS):
        n_side = WINDOWS[g] // (2 * DILATIONS[g])
        o_g, l_g = dilated_group_attn(q[:, :, g], k[:, :, g], v[:, :, g],
                                      rel_bias[:, g * HEADS_PER_GROUP:(g + 1) * HEADS_PER_GROUP],
                                      DILATIONS[g], n_side)
        outs.append(o_g)
        lses.append(l_g)
    alpha = jax.nn.softmax(jnp.stack(lses), axis=0)
    y_at = jnp.einsum('gbsh,gbshd->bshd', alpha, jnp.stack(outs)).reshape(b, s, ATT_OUT).astype(h.dtype)
    gates = jax.nn.sigmoid(h @ w_gate + b_gate).reshape(b, s, N_BRANCH, D_MODEL)
    y = gates[:, :, 0] * (y_hy @ w_hy_proj) + gates[:, :, 1] * (y_at @ w_at_proj)
    return y @ w_out


def setup_inputs(seed: int = 0) -> dict:
    key = jax.random.key(seed)
    ks = jax.random.split(key, 32)
    f32 = jnp.float32

    def nrm(k, shape, scale):
        return jax.random.normal(k, shape, f32) * scale

    def gain(k, shape):
        return 1.0 + 0.01 * jax.random.normal(k, shape, f32)

    L = DEPTH
    return {
        'x': nrm(ks[0], (BATCH, SEQ, D_MODEL), 1.0),
        'rel_bias': nrm(ks[1], (REL_BUCKETS, N_ATT_HEADS), 0.5),
        'ffn1_norm': gain(ks[2], (L, D_MODEL)),
        'ffn1_w_gate': nrm(ks[3], (L, D_MODEL, D_FF), D_MODEL ** -0.5),
        'ffn1_w_up': nrm(ks[4], (L, D_MODEL, D_FF), D_MODEL ** -0.5),
        'ffn1_w_down': nrm(ks[5], (L, D_FF, D_MODEL), D_FF ** -0.5),
        'mix_norm': gain(ks[6], (L, D_MODEL)),
        'w_in': nrm(ks[7], (L, D_MODEL, IN_WIDTH), D_MODEL ** -0.5),
        'w_gate': nrm(ks[8], (L, D_MODEL, N_BRANCH * D_MODEL), D_MODEL ** -0.5),
        'b_gate': nrm(ks[9], (L, N_BRANCH * D_MODEL), 0.01),
        'hy_conv_w': nrm(ks[10], (L, 3, 3 * HY_WIDTH), 3 ** -0.5),
        'hy_conv_b': nrm(ks[11], (L, 3 * HY_WIDTH), 0.01),
        'hy_filt_w1': nrm(ks[12], (L, HY_EMB, HY_FILT_HIDDEN), HY_EMB ** -0.5),
        'hy_filt_b1': nrm(ks[13], (L, HY_FILT_HIDDEN), 0.01),
        'hy_filt_w2': nrm(ks[14], (L, HY_FILT_HIDDEN, HY_FILT_HIDDEN), HY_FILT_HIDDEN ** -0.5),
        'hy_filt_b2': nrm(ks[15], (L, HY_FILT_HIDDEN), 0.01),
        'hy_filt_w3': nrm(ks[16], (L, HY_FILT_HIDDEN, HY_ORDER * 2 * HY_WIDTH), HY_FILT_HIDDEN ** -0.5),
        'hy_skip': nrm(ks[17], (L, HY_ORDER, HY_WIDTH), 1.0),
        'q_norm': gain(ks[18], (L, HEAD_DIM)),
        'k_norm': gain(ks[19], (L, HEAD_DIM)),
        'w_hy_proj': nrm(ks[20], (L, HY_WIDTH, D_MODEL), HY_WIDTH ** -0.5),
        'w_at_proj': nrm(ks[21], (L, ATT_OUT, D_MODEL), ATT_OUT ** -0.5),
        'w_out': nrm(ks[22], (L, D_MODEL, D_MODEL), D_MODEL ** -0.5),
        'ffn2_norm': gain(ks[23], (L, D_MODEL)),
        'ffn2_w_gate': nrm(ks[24], (L, D_MODEL, D_FF), D_MODEL ** -0.5),
        'ffn2_w_up': nrm(ks[25], (L, D_MODEL, D_FF), D_MODEL ** -0.5),
        'ffn2_w_down': nrm(ks[26], (L, D_FF, D_MODEL), D_FF ** -0.5),
    }


def reference(x, rel_bias, ffn1_norm, ffn1_w_gate, ffn1_w_up, ffn1_w_down, mix_norm, w_in, w_gate, b_gate,
              hy_conv_w, hy_conv_b, hy_filt_w1, hy_filt_b1, hy_filt_w2, hy_filt_b2, hy_filt_w3, hy_skip,
              q_norm, k_norm, w_hy_proj, w_at_proj, w_out, ffn2_norm, ffn2_w_gate, ffn2_w_up, ffn2_w_down):
    for l in range(DEPTH):
        x = x + 0.5 * swiglu(rms_norm(x, ffn1_norm[l]), ffn1_w_gate[l], ffn1_w_up[l], ffn1_w_down[l])
        h = rms_norm(x, mix_norm[l])
        x = x + hybrid_mixer(h, rel_bias, w_in[l], w_gate[l], b_gate[l], hy_conv_w[l], hy_conv_b[l],
                             hy_filt_w1[l], hy_filt_b1[l], hy_filt_w2[l], hy_filt_b2[l], hy_filt_w3[l],
                             hy_skip[l], q_norm[l], k_norm[l], w_hy_proj[l], w_at_proj[l], w_out[l])
        x = x + 0.5 * swiglu(rms_norm(x, ffn2_norm[l]), ffn2_w_gate[l], ffn2_w_up[l], ffn2_w_down[l])
    return x
```

```cpp
#include <hip/hip_runtime.h>
#include <hip/hip_cooperative_groups.h>
#include <cstdio>
#include <cstdint>
namespace cg = cooperative_groups;

#define LAS __attribute__((address_space(3)))
typedef unsigned short bf16_t;
typedef short bf16x8 __attribute__((ext_vector_type(8)));
typedef float f32x4 __attribute__((ext_vector_type(4)));
typedef float f32x16 __attribute__((ext_vector_type(16)));
typedef unsigned u32x4 __attribute__((ext_vector_type(4)));
typedef unsigned u32x2 __attribute__((ext_vector_type(2)));

constexpr int DM = 1024, NB = 8, SEQ = 4096, TT = NB * SEQ, DFF = 2688, NLAYER = 2;
constexpr int HYW = 512, INW = 3840, QKVW = 2304, GATEW = 2048;
constexpr float EPS = 1e-6f;

constexpr size_t MiB = 1u << 20;
constexpr size_t WS_SSQ = 0;
constexpr size_t WS_HID = 2 * MiB;
constexpr size_t WS_BTAB = 4 * MiB;
constexpr size_t WS_BAR = 4 * MiB + 65536;
constexpr size_t WS_FPART = 4 * MiB + 524288;
constexpr size_t WS_W = 5 * MiB;
constexpr size_t W_UP1 = 0, W_DN1 = W_UP1 + (size_t)2 * DFF * DM * 2, W_IN = W_DN1 + (size_t)DM * DFF * 2,
                 W_HY = W_IN + (size_t)(INW + GATEW) * DM * 2, W_AT = W_HY + (size_t)DM * 512 * 2, W_OUT = W_AT + (size_t)DM * 256 * 2,
                 W_UP2 = W_OUT + (size_t)DM * DM * 2, W_DN2 = W_UP2 + (size_t)2 * DFF * DM * 2, W_END = W_DN2 + (size_t)DM * DFF * 2;
static_assert(W_END <= 47 * MiB, "weights region");
constexpr size_t WS_XB = 52 * MiB;
constexpr size_t WS_OG = WS_XB;
constexpr size_t WS_LSE = WS_XB + 48 * MiB;
constexpr size_t WS_BIG = 116 * MiB;
constexpr size_t WS_H = WS_BIG;
constexpr size_t WS_PT = WS_BIG;
constexpr size_t WS_QKV = WS_BIG + 96 * MiB;
constexpr size_t WS_G = WS_QKV + 144 * MiB;
constexpr size_t WS_YHY = WS_QKV;
constexpr size_t WS_YAT = WS_QKV + 32 * MiB;
constexpr size_t WS_Y = WS_QKV + 48 * MiB;
constexpr size_t WS_GBUF = WS_G + 128 * MiB;
constexpr size_t WS_END = WS_GBUF + 16 * MiB;

constexpr int LDS_RS = 131072, LDS_MISC = LDS_RS + 16384, LDS_BYTES = LDS_MISC + 1024;

__device__ __forceinline__ unsigned pk2(float lo, float hi) {
    typedef float f2 __attribute__((ext_vector_type(2))); typedef __bf16 b2 __attribute__((ext_vector_type(2)));
    f2 v = {lo, hi}; b2 b = __builtin_convertvector(v, b2); return __builtin_bit_cast(unsigned, b);
}
__device__ __forceinline__ float bf_lo(unsigned w) { return __uint_as_float(w << 16); }
__device__ __forceinline__ float bf_hi(unsigned w) { return __uint_as_float(w & 0xffff0000u); }
__device__ __forceinline__ float bf1(bf16_t h) { return __uint_as_float(((unsigned)h) << 16); }
__device__ __forceinline__ float shx(float v, int mask) {
    int l; asm volatile("v_mbcnt_lo_u32_b32 %0, -1, 0\n\tv_mbcnt_hi_u32_b32 %0, -1, %0" : "=v"(l));
    return __int_as_float(__builtin_amdgcn_ds_bpermute((l ^ mask) << 2, __float_as_int(v)));
}
__device__ __forceinline__ float shx1(float v) { return __int_as_float(__builtin_amdgcn_update_dpp(0, __float_as_int(v), 0xB1, 0xF, 0xF, false)); }
__device__ __forceinline__ float wave_sum(float v) {
#define WS_DPP(x, ctrl, rmask) __int_as_float(__builtin_amdgcn_update_dpp(0, __float_as_int(x), ctrl, rmask, 0xF, false))
    v += WS_DPP(v, 0xB1, 0xF);
    v += WS_DPP(v, 0x4E, 0xF);
    v += WS_DPP(v, 0x141, 0xF);
    v += WS_DPP(v, 0x140, 0xF);
    v += WS_DPP(v, 0x142, 0xA);
    v += WS_DPP(v, 0x143, 0xC);
#undef WS_DPP
    return __int_as_float(__builtin_amdgcn_readlane(__float_as_int(v), 63));
}
__device__ __forceinline__ float sigmoidf_(float x) { return __builtin_amdgcn_rcpf(1.f + __builtin_amdgcn_exp2f(x * -1.4426950408889634f)); }
__device__ __forceinline__ float row_rstd_q(const float* part, int row, int fq) {
    const f32x4 a = *(const f32x4*)(part + (size_t)row * 16 + 4 * fq);
    float s = (a[0] + a[1]) + (a[2] + a[3]);
    s += shx(s, 16); s += shx(s, 32);
    return rsqrtf(s * (1.0f / 1024.0f) + 1e-6f);
}
__device__ __forceinline__ float row_rstd(const float* part, int row) {
    const f32x4* p = (const f32x4*)(part + (size_t)row * 16);
    const f32x4 a = p[0], b = p[1], c = p[2], d = p[3];
    const float s = ((a[0] + a[1]) + (a[2] + a[3])) + ((b[0] + b[1]) + (b[2] + b[3])) + ((c[0] + c[1]) + (c[2] + c[3])) + ((d[0] + d[1]) + (d[2] + d[3]));
    return rsqrtf(s * (1.0f / 1024.0f) + 1e-6f);
}

namespace pg8 {
constexpr int BM = 256, BK = 64, HALF = 128, HTB = HALF * BK * 2, STAGE_BYTES = 8 * HTB, NXCD = 8, WGM = 8;
__host__ __device__ __forceinline__ int lds_byte(int r, int c) { const int st = (r >> 4) * 2 + (c >> 5), rr = r & 15, cc = c & 31, ob = rr * 64 + cc * 2; return st * 1024 + (ob ^ (((ob >> 9) & 1) << 5)); }
__host__ __device__ __forceinline__ void stage_rc(int b, int& R, int& C) { const int st = b / 1024, sb = b % 1024, swz = sb ^ (((sb >> 9) & 1) << 5); R = (st >> 1) * 16 + swz / 64; C = (st & 1) * 32 + (swz % 64) / 2; }
__host__ __device__ __forceinline__ int perm32(int rho) { const int n = rho >> 4, i = rho & 15; return 8 * (i >> 2) + 4 * n + (i & 3); }

struct Unit { int pm, pn; };
struct Gemm { const bf16_t* A; const bf16_t* Bt; int M, N, K; };

struct StaticOrder {
    int nM, nN, nwg, G, c;
    __device__ void init(int M, int N, int G_, int c_) { nM = M / BM; nN = N / BM; nwg = nM * nN; G = G_; c = c_; }
    __device__ bool next(int i, Unit& u) const {
        const long L = (long)i * G + c; if (L >= nwg) return false;
        int wgid = (int)L; { const int q = nwg / NXCD, r = nwg % NXCD, xcd = wgid % NXCD, off = wgid / NXCD; wgid = (xcd < r ? xcd * (q + 1) : r * (q + 1) + (xcd - r) * q) + off; }
        const int nig = WGM * nN, gid = wgid / nig, fm = gid * WGM, gsz = (nM - fm) < WGM ? (nM - fm) : WGM;
        u.pm = fm + ((wgid % nig) % gsz); u.pn = (wgid % nig) / gsz; return true;
    }
    __device__ __forceinline__ void a_ready(const Unit&) const {}
    __device__ __forceinline__ void done(const Unit&) const {}
};


struct EpiFfnUp {
    static constexpr bool PERM = true;
    bf16_t* H; const float* ssq; const LAS float* rstab; int rsbase;
    __device__ __forceinline__ void operator()(const f32x4 (&acc)[2][2][4][2], const Unit& u, int wr, int wc, int fr, int fq) const {
        const int row0 = u.pm * BM + wr * 64 + fr, col0 = u.pn * 128 + wc * 32 + 8 * fq;
#pragma unroll
        for (int ai = 0; ai < 2; ++ai)
#pragma unroll
            for (int m = 0; m < 4; ++m) {
                const int row = row0 + ai * HALF + m * 16;
                const float rs = rstab ? rstab[row - rsbase] : row_rstd_q(ssq, row, fq);
                float h[8];
#pragma unroll
                for (int n = 0; n < 2; ++n)
#pragma unroll
                    for (int e = 0; e < 4; ++e) { const float g = acc[ai][0][m][n][e] * rs, up = acc[ai][1][m][n][e] * rs; h[n * 4 + e] = g * sigmoidf_(g) * up; }
                u32x4 w; w.x = pk2(h[0], h[1]); w.y = pk2(h[2], h[3]); w.z = pk2(h[4], h[5]); w.w = pk2(h[6], h[7]);
                *(u32x4*)(H + (size_t)row * DFF + col0) = w;
            }
    }
};
struct EpiResid {
    static constexpr bool PERM = false;
    const float* Xin; float* Xout; bf16_t* XB; float* ssq; float alpha;
    __device__ __forceinline__ void ldb(f32x4 (&xi)[2][2][2], int row0, int col0, int bt) const {
        const int ai = bt >> 1, mh = bt & 1;
#pragma unroll
        for (int mm = 0; mm < 2; ++mm)
#pragma unroll
            for (int bj = 0; bj < 2; ++bj)
#pragma unroll
                for (int n = 0; n < 2; ++n) xi[mm][bj][n] = *(const f32x4*)(Xin + (size_t)(row0 + ai * HALF + (2 * mh + mm) * 16) * DM + col0 + bj * HALF + n * 16);
    }
    __device__ __forceinline__ void stb(const f32x4 (&xi)[2][2][2], const f32x4 (&acc)[2][2][4][2], const Unit& u, int wc, int fq, int row0, int col0, int bt) const {
        const int ai = bt >> 1, mh = bt & 1;
#pragma unroll
        for (int mm = 0; mm < 2; ++mm) {
            const int m = 2 * mh + mm, row = row0 + ai * HALF + m * 16; float s = 0.f;
#pragma unroll
            for (int bj = 0; bj < 2; ++bj)
#pragma unroll
                for (int n = 0; n < 2; ++n) {
                    const size_t off = (size_t)row * DM + col0 + bj * HALF + n * 16;
                    const f32x4 v = xi[mm][bj][n] + acc[ai][bj][m][n] * alpha;
                    *(f32x4*)(Xout + off) = v;
                    u32x2 w; w.x = pk2(v[0], v[1]); w.y = pk2(v[2], v[3]);
                    *(u32x2*)(XB + off) = w;
                    s += (v[0] * v[0] + v[1] * v[1]) + (v[2] * v[2] + v[3] * v[3]);
                }
            if (ssq) { s += shx(s, 16); s += shx(s, 32); if (fq == 0) ssq[(size_t)row * 16 + u.pn * 4 + wc] = s; }
        }
    }
    __device__ __forceinline__ void operator()(const f32x4 (&acc)[2][2][4][2], const Unit& u, int wr, int wc, int fr, int fq) const {
        const int row0 = u.pm * BM + wr * 64 + fr, col0 = u.pn * BM + wc * 32 + 4 * fq;
        f32x4 xa[2][2][2], xb[2][2][2];
        ldb(xa, row0, col0, 0); ldb(xb, row0, col0, 1);
        asm volatile("" ::: "memory");
        stb(xa, acc, u, wc, fq, row0, col0, 0); ldb(xa, row0, col0, 2);
        asm volatile("" ::: "memory");
        stb(xb, acc, u, wc, fq, row0, col0, 1); ldb(xb, row0, col0, 3);
        asm volatile("" ::: "memory");
        stb(xa, acc, u, wc, fq, row0, col0, 2);
        asm volatile("" ::: "memory");
        stb(xb, acc, u, wc, fq, row0, col0, 3);
    }
};
struct EpiWin {
    static constexpr bool PERM = true;
    bf16_t* PT; bf16_t* QKV; bf16_t* G; const float* ssq; const float* bgate; const LAS float* rstab; int rsbase;
    __device__ __forceinline__ void operator()(const f32x4 (&acc)[2][2][4][2], const Unit& u, int wr, int wc, int fr, int fq) const {
        const int row0 = u.pm * BM + wr * 64 + fr, colt = u.pn * BM + wc * 32 + 8 * fq;
        if (u.pn < 6) {
            const bool odd = fr & 1;
#pragma unroll
            for (int ai = 0; ai < 2; ++ai)
#pragma unroll
                for (int m = 0; m < 4; ++m) {
                    const int row = row0 + ai * HALF + m * 16;
                    const float rs = rstab ? rstab[row - rsbase] : row_rstd_q(ssq, row, fq);
                    const int rowp = row & ~1;
#pragma unroll
                    for (int bj = 0; bj < 2; ++bj)
#pragma unroll
                        for (int n = 0; n < 2; ++n) {
                            const f32x4 v = acc[ai][bj][m][n] * rs;
                            const float s0 = odd ? v[0] : v[2], s1 = odd ? v[1] : v[3];
                            const float r0 = shx1(s0), r1 = shx1(s1);
                            const float k0 = odd ? v[2] : v[0], k1 = odd ? v[3] : v[1];
                            const int col = colt + bj * HALF + 4 * n + (odd ? 2 : 0);
                            const unsigned w0 = odd ? pk2(r0, k0) : pk2(k0, r0), w1 = odd ? pk2(r1, k1) : pk2(k1, r1);
                            *(unsigned*)(PT + (size_t)col * TT + rowp) = w0;
                            *(unsigned*)(PT + (size_t)(col + 1) * TT + rowp) = w1;
                        }
                }
        } else if (u.pn < 15) {
#pragma unroll
            for (int ai = 0; ai < 2; ++ai)
#pragma unroll
                for (int m = 0; m < 4; ++m) {
                    const int row = row0 + ai * HALF + m * 16;
                    const float rs = rstab ? rstab[row - rsbase] : row_rstd_q(ssq, row, fq);
#pragma unroll
                    for (int bj = 0; bj < 2; ++bj) {
                        const f32x4 v0 = acc[ai][bj][m][0] * rs, v1 = acc[ai][bj][m][1] * rs;
                        u32x4 w; w.x = pk2(v0[0], v0[1]); w.y = pk2(v0[2], v0[3]); w.z = pk2(v1[0], v1[1]); w.w = pk2(v1[2], v1[3]);
                        *(u32x4*)(QKV + (size_t)row * QKVW + (colt - 1536 + bj * HALF)) = w;
                    }
                }
        } else {
            f32x4 bv[2][2];
#pragma unroll
            for (int bj = 0; bj < 2; ++bj)
#pragma unroll
                for (int n = 0; n < 2; ++n) bv[bj][n] = *(const f32x4*)(bgate + (colt - INW + bj * HALF + 4 * n));
#pragma unroll
            for (int ai = 0; ai < 2; ++ai)
#pragma unroll
                for (int m = 0; m < 4; ++m) {
                    const int row = row0 + ai * HALF + m * 16;
                    const float rs = rstab ? rstab[row - rsbase] : row_rstd_q(ssq, row, fq);
#pragma unroll
                    for (int bj = 0; bj < 2; ++bj) {
                        const f32x4 v0 = acc[ai][bj][m][0] * rs + bv[bj][0], v1 = acc[ai][bj][m][1] * rs + bv[bj][1];
                        u32x4 w; w.x = pk2(sigmoidf_(v0[0]), sigmoidf_(v0[1])); w.y = pk2(sigmoidf_(v0[2]), sigmoidf_(v0[3]));
                        w.z = pk2(sigmoidf_(v1[0]), sigmoidf_(v1[1])); w.w = pk2(sigmoidf_(v1[2]), sigmoidf_(v1[3]));
                        *(u32x4*)(G + (size_t)row * GATEW + (colt - INW + bj * HALF)) = w;
                    }
                }
        }
    }
};
template <bool ADD> struct EpiMerge {
    static constexpr bool PERM = true;
    bf16_t* Y; const bf16_t* G; int goff;
    __device__ __forceinline__ void operator()(const f32x4 (&acc)[2][2][4][2], const Unit& u, int wr, int wc, int fr, int fq) const {
        const int row0 = u.pm * BM + wr * 64 + fr, colt = u.pn * BM + wc * 32 + 8 * fq;
#pragma unroll
        for (int ai = 0; ai < 2; ++ai)
#pragma unroll
            for (int m = 0; m < 4; ++m) {
                const int row = row0 + ai * HALF + m * 16;
#pragma unroll
                for (int bj = 0; bj < 2; ++bj) {
                    const int col = colt + bj * HALF;
                    const u32x4 gw = *(const u32x4*)(G + (size_t)row * GATEW + goff + col);
                    const f32x4 a0 = acc[ai][bj][m][0], a1 = acc[ai][bj][m][1];
                    float o[8];
                    o[0] = bf_lo(gw.x) * a0[0]; o[1] = bf_hi(gw.x) * a0[1]; o[2] = bf_lo(gw.y) * a0[2]; o[3] = bf_hi(gw.y) * a0[3];
                    o[4] = bf_lo(gw.z) * a1[0]; o[5] = bf_hi(gw.z) * a1[1]; o[6] = bf_lo(gw.w) * a1[2]; o[7] = bf_hi(gw.w) * a1[3];
                    u32x4* yp = (u32x4*)(Y + (size_t)row * DM + col);
                    if (ADD) { const u32x4 yw = *yp;
                        o[0] += bf_lo(yw.x); o[1] += bf_hi(yw.x); o[2] += bf_lo(yw.y); o[3] += bf_hi(yw.y);
                        o[4] += bf_lo(yw.z); o[5] += bf_hi(yw.z); o[6] += bf_lo(yw.w); o[7] += bf_hi(yw.w); }
                    u32x4 w; w.x = pk2(o[0], o[1]); w.y = pk2(o[2], o[3]); w.z = pk2(o[4], o[5]); w.w = pk2(o[6], o[7]);
                    *yp = w;
                }
            }
    }
};

template <class Epi, class Sched, bool ALIGN_EPI = true, bool SP2 = true>
__device__ __forceinline__ void gemm_phase(LAS unsigned char* lds, const Gemm g, const Sched& S, const Epi& E, const int tid) {
    const int wid = __builtin_amdgcn_readfirstlane(tid >> 6), lane = tid & 63, wr = wid >> 2, wc = wid & 3, fr = lane & 15, fq = lane >> 4;
    const int K = g.K, nt = K / BK;
    unsigned voffA[2], voffB[2];
#pragma unroll
    for (int i = 0; i < 2; ++i) { int R, C; stage_rc(tid * 16 + i * 8192, R, C); const int Rb = Epi::PERM ? ((R & ~31) + perm32(R & 31)) : R;
        voffA[i] = (unsigned)(R * K + C) * 2u; voffB[i] = (unsigned)(Rb * K + C) * 2u; }
    const size_t kstep = (size_t)(BK * 2);
    const size_t hstep = (size_t)HALF * K * 2;
    const size_t tstep = 2 * hstep;
    const unsigned ldsw = (unsigned)wid * 1024u;
    const int aoff = lds_byte(wr * 64 + fr, fq * 8), boff = lds_byte(wc * 32 + fr, fq * 8);
#define PG8_SA(b, h) (((b) * 2 + (h)) * HTB)
#define PG8_SB(b, h) ((4 + (b) * 2 + (h)) * HTB)
#define PG8_STAGE(bufoff, gbase, voff) do { _Pragma("unroll") for (int _i = 0; _i < 2; ++_i) \
        __builtin_amdgcn_global_load_lds((const unsigned*)((const char*)(gbase) + (voff)[_i]), (LAS unsigned*)(lds + (bufoff) + ldsw + _i * 8192), 16, 0, 0); } while (0)
#define PG8_LDA(dst, b, h) do { _Pragma("unroll") for (int m = 0; m < 4; ++m) _Pragma("unroll") for (int k = 0; k < 2; ++k) dst[m][k] = *(const LAS bf16x8*)(lds + PG8_SA(b, h) + aoff + m * 2048 + k * 1024); } while (0)
#define PG8_LDB(dst, b, h) do { _Pragma("unroll") for (int n = 0; n < 2; ++n) _Pragma("unroll") for (int k = 0; k < 2; ++k) dst[n][k] = *(const LAS bf16x8*)(lds + PG8_SB(b, h) + boff + n * 2048 + k * 1024); } while (0)
#define PG8_MMA(ai, bj, At, Bt) do { __builtin_amdgcn_s_setprio(1); _Pragma("unroll") for (int m = 0; m < 4; ++m) _Pragma("unroll") for (int n = 0; n < 2; ++n) _Pragma("unroll") for (int k = 0; k < 2; ++k) \
        acc[ai][bj][m][n] = __builtin_amdgcn_mfma_f32_16x16x32_bf16(Bt[n][k], At[m][k], acc[ai][bj][m][n], 0, 0, 0); __builtin_amdgcn_s_setprio(0); } while (0)
#define PG8_WAIT_V(n) asm volatile("s_waitcnt vmcnt(" #n ")" ::: "memory")
#define PG8_WAIT_L(n) asm volatile("s_waitcnt lgkmcnt(" #n ")" ::: "memory")
#define PG8_BAR __builtin_amdgcn_s_barrier()
#define PG8_SCHED __builtin_amdgcn_sched_barrier(0)
    Unit cur, nxt; int ui = 0;
    if (!S.next(0, cur)) return;
    f32x4 acc[2][2][4][2];
#pragma unroll
    for (int a = 0; a < 2; ++a)
#pragma unroll
        for (int b = 0; b < 2; ++b)
#pragma unroll
            for (int m = 0; m < 4; ++m)
#pragma unroll
                for (int n = 0; n < 2; ++n) acc[a][b][m][n] = (f32x4){0.f, 0.f, 0.f, 0.f};
    bf16x8 At[4][2], B0[2][2], B1[2][2];
    const char* cA = (const char*)g.A + (size_t)cur.pm * tstep; const char* cB = (const char*)g.Bt + (size_t)cur.pn * tstep;
    S.a_ready(cur);
    if constexpr (SP2) {
        PG8_STAGE(PG8_SB(0, 0), cB, voffB); PG8_STAGE(PG8_SB(0, 1), cB + hstep, voffB); PG8_STAGE(PG8_SA(0, 0), cA, voffA); PG8_STAGE(PG8_SA(0, 1), cA + hstep, voffA);
        if (wr == 1) PG8_BAR;
        PG8_WAIT_V(2); PG8_BAR;
        PG8_STAGE(PG8_SB(1, 0), cB + kstep, voffB); PG8_STAGE(PG8_SA(1, 0), cA + kstep, voffA); PG8_STAGE(PG8_SB(1, 1), cB + hstep + kstep, voffB);
        PG8_WAIT_V(6); PG8_BAR;
    } else {
        PG8_STAGE(PG8_SB(0, 0), cB, voffB); PG8_STAGE(PG8_SA(0, 0), cA, voffA); PG8_STAGE(PG8_SB(0, 1), cB + hstep, voffB); PG8_STAGE(PG8_SA(0, 1), cA + hstep, voffA);
        if (wr == 1) PG8_BAR;
        PG8_WAIT_V(4); PG8_BAR;
        PG8_STAGE(PG8_SB(1, 0), cB + kstep, voffB); PG8_STAGE(PG8_SA(1, 0), cA + kstep, voffA); PG8_STAGE(PG8_SB(1, 1), cB + hstep + kstep, voffB);
        PG8_WAIT_V(6); PG8_BAR;
    }
    for (;;) {
        const bool has_next = S.next(ui + 1, nxt);
        const char* nA = has_next ? (const char*)g.A + (size_t)nxt.pm * tstep : cA; const char* nB = has_next ? (const char*)g.Bt + (size_t)nxt.pn * tstep : cB;
        for (int t = 0; t < nt; t += 2) {
            const bool last = (t == nt - 2);
            const char* a1 = cA + (size_t)(t + 1) * kstep;
            const char* a2 = last ? nA : cA + (size_t)(t + 2) * kstep; const char* b2 = last ? nB : cB + (size_t)(t + 2) * kstep;
            const char* a3 = a2 + kstep; const char* b3 = b2 + kstep;
            if (last && has_next) S.a_ready(nxt);
            if constexpr (SP2) {
            PG8_LDB(B0, 0, 0); PG8_LDB(B1, 0, 1); PG8_SCHED; PG8_LDA(At, 0, 0); PG8_STAGE(PG8_SA(1, 1), a1 + hstep, voffA);
            PG8_WAIT_V(8); PG8_WAIT_L(0); PG8_BAR; PG8_MMA(0, 0, At, B0); PG8_MMA(0, 1, At, B1); PG8_BAR; PG8_SCHED;
            PG8_LDA(At, 0, 1); PG8_STAGE(PG8_SB(0, 0), b2, voffB); PG8_STAGE(PG8_SB(0, 1), b2 + hstep, voffB); PG8_STAGE(PG8_SA(0, 0), a2, voffA);
            PG8_WAIT_V(8); PG8_WAIT_L(0); PG8_BAR; PG8_MMA(1, 0, At, B0); PG8_MMA(1, 1, At, B1); PG8_BAR; PG8_SCHED;
            PG8_LDB(B0, 1, 0); PG8_LDB(B1, 1, 1); PG8_SCHED; PG8_LDA(At, 1, 0); PG8_STAGE(PG8_SA(0, 1), a2 + hstep, voffA);
            PG8_WAIT_V(8); PG8_WAIT_L(0); PG8_BAR; PG8_MMA(0, 0, At, B0); PG8_MMA(0, 1, At, B1); PG8_BAR; PG8_SCHED;
            PG8_LDA(At, 1, 1); PG8_STAGE(PG8_SB(1, 0), b3, voffB); PG8_STAGE(PG8_SB(1, 1), b3 + hstep, voffB); PG8_STAGE(PG8_SA(1, 0), a3, voffA);
            PG8_WAIT_V(8); PG8_WAIT_L(0); PG8_BAR; PG8_MMA(1, 0, At, B0); PG8_MMA(1, 1, At, B1); PG8_BAR; PG8_SCHED;
            } else {
            PG8_LDB(B0, 0, 0); PG8_SCHED; PG8_LDA(At, 0, 0); PG8_STAGE(PG8_SA(1, 1), a1 + hstep, voffA);
            PG8_WAIT_L(8); PG8_BAR; PG8_WAIT_L(0); PG8_MMA(0, 0, At, B0); PG8_BAR; PG8_SCHED;
            PG8_LDB(B1, 0, 1); PG8_STAGE(PG8_SB(0, 0), b2, voffB);
            PG8_BAR; PG8_WAIT_L(0); PG8_MMA(0, 1, At, B1); PG8_BAR;
            PG8_LDA(At, 0, 1); PG8_STAGE(PG8_SA(0, 0), a2, voffA);
            PG8_BAR; PG8_WAIT_L(0); PG8_MMA(1, 0, At, B0); PG8_BAR; PG8_SCHED;
            PG8_STAGE(PG8_SB(0, 1), b2 + hstep, voffB);
            PG8_WAIT_V(6); PG8_BAR; PG8_MMA(1, 1, At, B1); PG8_BAR;
            PG8_LDB(B0, 1, 0); PG8_SCHED; PG8_LDA(At, 1, 0); PG8_STAGE(PG8_SA(0, 1), a2 + hstep, voffA);
            PG8_WAIT_L(8); PG8_BAR; PG8_WAIT_L(0); PG8_MMA(0, 0, At, B0); PG8_BAR; PG8_SCHED;
            PG8_LDB(B1, 1, 1); PG8_STAGE(PG8_SB(1, 0), b3, voffB);
            PG8_BAR; PG8_WAIT_L(0); PG8_MMA(0, 1, At, B1); PG8_BAR;
            PG8_LDA(At, 1, 1); PG8_STAGE(PG8_SA(1, 0), a3, voffA);
            PG8_BAR; PG8_WAIT_L(0); PG8_MMA(1, 0, At, B0); PG8_BAR; PG8_SCHED;
            PG8_STAGE(PG8_SB(1, 1), b3 + hstep, voffB);
            PG8_WAIT_V(6); PG8_BAR; PG8_MMA(1, 1, At, B1); PG8_BAR;
            }
        }
        if constexpr (ALIGN_EPI) { if (wr == 0) PG8_BAR; }
        { int l2; asm volatile("v_mbcnt_lo_u32_b32 %0, -1, 0\n\tv_mbcnt_hi_u32_b32 %0, -1, %0" : "=v"(l2));
          E(acc, cur, wr, wc, l2 & 15, l2 >> 4);
          } S.done(cur);
        if (!has_next) break;
#pragma unroll
        for (int a = 0; a < 2; ++a)
#pragma unroll
            for (int b = 0; b < 2; ++b)
#pragma unroll
                for (int m = 0; m < 4; ++m)
#pragma unroll
                    for (int n = 0; n < 2; ++n) acc[a][b][m][n] = (f32x4){0.f, 0.f, 0.f, 0.f};
        cur = nxt; cA = nA; cB = nB; ++ui;
        if constexpr (ALIGN_EPI) { if (wr == 1) PG8_BAR; }
    }
    PG8_WAIT_V(0);
    if constexpr (!ALIGN_EPI) { if (wr == 0) PG8_BAR; }
    PG8_BAR;
#undef PG8_SA
#undef PG8_SB
#undef PG8_STAGE
#undef PG8_LDA
#undef PG8_LDB
#undef PG8_MMA
#undef PG8_WAIT_V
#undef PG8_WAIT_L
#undef PG8_BAR
#undef PG8_SCHED
}
}


template <class Sched>
__device__ __forceinline__ const LAS float* build_rstd_table(LAS unsigned char* lds, const Sched& S, const float* ssq, int tid, int& rsbase) {
    int pmin = 1 << 30, pmax = -1; pg8::Unit u;
    for (int i = 0; S.next(i, u); ++i) { pmin = u.pm < pmin ? u.pm : pmin; pmax = u.pm > pmax ? u.pm : pmax; }
    rsbase = pmin * 256;
    const int nrows = (pmax - pmin + 1) * 256;
    if (pmax < 0 || nrows > 4096) return nullptr;
    LAS float* tab = (LAS float*)(lds + LDS_RS);
    {
        f32x4 pv[8][4];
#pragma unroll
        for (int k = 0; k < 8; ++k) { const int r = tid + 512 * k; const f32x4* p = (const f32x4*)(ssq + (size_t)(rsbase + (r < nrows ? r : 0)) * 16);
#pragma unroll
            for (int q = 0; q < 4; ++q) pv[k][q] = p[q]; }
#pragma unroll
        for (int k = 0; k < 8; ++k) { const int r = tid + 512 * k;
            const f32x4 a = pv[k][0], b = pv[k][1], c = pv[k][2], d = pv[k][3];
            const float sm = ((a[0] + a[1]) + (a[2] + a[3])) + ((b[0] + b[1]) + (b[2] + b[3])) + ((c[0] + c[1]) + (c[2] + c[3])) + ((d[0] + d[1]) + (d[2] + d[3]));
            if (r < nrows) tab[r] = rsqrtf(sm * (1.0f / 1024.0f) + 1e-6f); }
    }
    __syncthreads();
    return tab;
}

struct Args { const float* in[27]; float* out; unsigned char* ws; int ph_lo, ph_hi; };
typedef const __attribute__((address_space(4))) Args* ArgP;
enum { I_X = 0, I_RELB, I_F1N, I_F1G, I_F1U, I_F1D, I_MIXN, I_WIN, I_WGATE, I_BGATE, I_CONVW, I_CONVB, I_FW1, I_FB1, I_FW2, I_FB2, I_FW3, I_SKIP,
       I_QN, I_KN, I_WHY, I_WAT, I_WOUT, I_F2N, I_F2G, I_F2U, I_F2D };

__device__ __forceinline__ void tr_item(const float* W, int K, int N, bf16_t* WT, int dest_row0, const float* gain, LAS float* scr, int k0, int n0, int lane) {
    float v[32];
    const float* wp = W + (size_t)(k0 + (lane >> 5)) * N + n0 + (lane & 31);
#pragma unroll
    for (int i = 0; i < 32; ++i) v[i] = wp[(size_t)(2 * i) * N];
    if (gain) {
#pragma unroll
        for (int i = 0; i < 32; ++i) v[i] *= gain[k0 + 2 * i + (lane >> 5)];
    }
#pragma unroll
    for (int i = 0; i < 32; ++i) scr[(2 * i + (lane >> 5)) * 33 + (lane & 31)] = v[i];
    asm volatile("s_waitcnt lgkmcnt(0)" ::: "memory");
    const int c = lane & 7;
#pragma unroll
    for (int j = 0; j < 4; ++j) { const int n = (lane >> 3) + 8 * j; const LAS float* s = scr + (8 * c) * 33 + n;
        u32x4 o; o.x = pk2(s[0 * 33], s[1 * 33]); o.y = pk2(s[2 * 33], s[3 * 33]); o.z = pk2(s[4 * 33], s[5 * 33]); o.w = pk2(s[6 * 33], s[7 * 33]);
        *(u32x4*)(WT + (size_t)(dest_row0 + n) * K + k0 + 8 * c) = o; }
    asm volatile("s_waitcnt lgkmcnt(0)" ::: "memory");
}
__device__ __forceinline__ void tr_matrix(const float* W, int K, int N, bf16_t* WT, int row_off, int mode, const float* gain, LAS float* scr, int gw, int ngw, int lane) {
    const int nblk = N / 32, nitems = (K / 64) * nblk;
    for (int it = gw; it < nitems; it += ngw) {
        const int kb = it / nblk, nb = it % nblk, n0 = 32 * nb;
        int dr = row_off + n0;
        if (mode) dr = 256 * (n0 >> 7) + (mode == 2 ? 128 : 0) + (n0 & 127);
        tr_item(W, K, N, WT, dr, gain, scr, 64 * kb, n0, lane);
    }
}
__device__ __forceinline__ void convert_weights(ArgP a, int l, int mask, LAS unsigned char* lds, int gw, int ngw, int wave, int lane) {
    LAS float* scr = (LAS float*)(lds + wave * 16384);
    bf16_t* wb = (bf16_t*)(a->ws + WS_W);
    if (mask & 1) {
        const float* g1 = a->in[I_F1N] + (size_t)l * DM;
        tr_matrix(a->in[I_F1G] + (size_t)l * DM * DFF, DM, DFF, (bf16_t*)((char*)wb + W_UP1), 0, 1, g1, scr, gw, ngw, lane);
        tr_matrix(a->in[I_F1U] + (size_t)l * DM * DFF, DM, DFF, (bf16_t*)((char*)wb + W_UP1), 0, 2, g1, scr, gw, ngw, lane);
        tr_matrix(a->in[I_F1D] + (size_t)l * DFF * DM, DFF, DM, (bf16_t*)((char*)wb + W_DN1), 0, 0, nullptr, scr, gw, ngw, lane);
        const float* gm = a->in[I_MIXN] + (size_t)l * DM;
        tr_matrix(a->in[I_WIN] + (size_t)l * DM * INW, DM, INW, (bf16_t*)((char*)wb + W_IN), 0, 0, gm, scr, gw, ngw, lane);
        tr_matrix(a->in[I_WGATE] + (size_t)l * DM * GATEW, DM, GATEW, (bf16_t*)((char*)wb + W_IN), INW, 0, gm, scr, gw, ngw, lane);
    }
    if (mask & 2) {
        tr_matrix(a->in[I_WHY] + (size_t)l * 512 * DM, 512, DM, (bf16_t*)((char*)wb + W_HY), 0, 0, nullptr, scr, gw, ngw, lane);
        tr_matrix(a->in[I_WAT] + (size_t)l * 256 * DM, 256, DM, (bf16_t*)((char*)wb + W_AT), 0, 0, nullptr, scr, gw, ngw, lane);
        tr_matrix(a->in[I_WOUT] + (size_t)l * DM * DM, DM, DM, (bf16_t*)((char*)wb + W_OUT), 0, 0, nullptr, scr, gw, ngw, lane);
        const float* g2 = a->in[I_F2N] + (size_t)l * DM;
        tr_matrix(a->in[I_F2G] + (size_t)l * DM * DFF, DM, DFF, (bf16_t*)((char*)wb + W_UP2), 0, 1, g2, scr, gw, ngw, lane);
        tr_matrix(a->in[I_F2U] + (size_t)l * DM * DFF, DM, DFF, (bf16_t*)((char*)wb + W_UP2), 0, 2, g2, scr, gw, ngw, lane);
        tr_matrix(a->in[I_F2D] + (size_t)l * DFF * DM, DFF, DM, (bf16_t*)((char*)wb + W_DN2), 0, 0, nullptr, scr, gw, ngw, lane);
    }
}

__device__ __forceinline__ int t5_bucket(int rel) {
    const int ret = rel > 0 ? 16 : 0; const int n = rel < 0 ? -rel : rel;
    const float nf = (float)(n > 1 ? n : 1);
    int large = 8 + (int)(logf(nf / 8.0f) / 4.852030263919617f * 8.0f);
    large = large < 15 ? large : 15;
    return ret + (n < 8 ? n : large);
}
__device__ __forceinline__ void prologue(ArgP a, LAS unsigned char* lds, int gw, int ngw, int wave, int lane) {
    float* ssq = (float*)(a->ws + WS_SSQ);
    bf16_t* XB = (bf16_t*)(a->ws + WS_XB);
    const float* x = a->in[I_X];
    for (int m0 = gw * 4; m0 < TT; m0 += ngw * 4) {
        f32x4 v[4][4];
#pragma unroll
        for (int rr = 0; rr < 4; ++rr) { const f32x4* xr = (const f32x4*)(x + (size_t)(m0 + rr) * DM) + lane;
#pragma unroll
            for (int j = 0; j < 4; ++j) v[rr][j] = xr[64 * j]; }
#pragma unroll
        for (int rr = 0; rr < 4; ++rr) {
            float s = 0.f; u32x2* o8 = (u32x2*)(XB + (size_t)(m0 + rr) * DM) + lane;
#pragma unroll
            for (int j = 0; j < 4; ++j) { const f32x4 q = v[rr][j]; s += (q[0] * q[0] + q[1] * q[1]) + (q[2] * q[2] + q[3] * q[3]);
                u32x2 w; w.x = pk2(q[0], q[1]); w.y = pk2(q[2], q[3]); o8[64 * j] = w; }
            s = wave_sum(s); if (lane < 16) ssq[(size_t)(m0 + rr) * 16 + lane] = lane == 0 ? s : 0.f;
        }
    }
    { float* bt = (float*)(a->ws + WS_BTAB); const float* rb = a->in[I_RELB];
      for (int i = gw * 64 + lane; i < 12 * 129; i += ngw * 64) { const int hd = i / 129, ri = i % 129, g = hd >> 2; const int rel = (ri - 64) * (1 << (2 * g));
          bt[hd * 132 + ri] = rb[t5_bucket(rel) * 12 + hd]; } }
    { float* hid = (float*)(a->ws + WS_HID);
      for (int it = gw; it < NLAYER * SEQ; it += ngw) {
          const int l = it / SEQ, pos = it % SEQ;
          const float* w1 = a->in[I_FW1] + (size_t)l * 33 * 64; const float* b1 = a->in[I_FB1] + l * 64;
          const float* w2 = a->in[I_FW2] + (size_t)l * 64 * 64; const float* b2 = a->in[I_FB2] + l * 64;
          const float t = (float)pos / 4095.0f; const float w = (6.283185307179586f / 4096.0f) * (float)pos;
          float z = 0.f;
          if (lane == 0) z = t;
          else if (lane <= 16) { const float f = 1e-4f + (float)(lane - 1) * ((15.0f - 1e-4f) / 15.0f); z = cosf(f * w); }
          else if (lane <= 32) { const float f = 1e-4f + (float)(lane - 17) * ((15.0f - 1e-4f) / 15.0f); z = -sinf(f * w); }
          float h1 = b1[lane];
#pragma unroll
          for (int i = 0; i < 33; ++i) h1 += __int_as_float(__builtin_amdgcn_readlane(__float_as_int(z), i)) * w1[i * 64 + lane];
          h1 = sinf(h1);
          float h2 = b2[lane];
#pragma unroll
          for (int i = 0; i < 64; ++i) h2 += __int_as_float(__builtin_amdgcn_readlane(__float_as_int(h1), i)) * w2[i * 64 + lane];
          h2 = sinf(h2);
          hid[((size_t)l * 64 + lane) * SEQ + pos] = h2;
      } }
    convert_weights(a, 0, 3, lds, gw, ngw, wave, lane);
}

constexpr int UT_STRIDE = 8192 + 16, HY_UT = 0, HY_ZERO = 8 * UT_STRIDE, HY_F = HY_ZERO + 128, COPY_STRIDE = 16448, HY_RED = HY_F + 4 * COPY_STRIDE;
static_assert(HY_RED + 64 <= LDS_BYTES && HY_F % 8 == 0 && COPY_STRIDE % 8 == 0, "hyena LDS map");

__device__ __forceinline__ void conv8(const bf16_t* base, int n0, float w0, float w1, float w2, float bias, float (&out)[8]) {
    const u32x4 pw = *(const u32x4*)(base + n0);
    float p[10];
    { const float hv = bf1(base[n0 > 0 ? n0 - 1 : 0]); p[0] = n0 > 0 ? hv : 0.f; }
    p[1] = bf_lo(pw.x); p[2] = bf_hi(pw.x); p[3] = bf_lo(pw.y); p[4] = bf_hi(pw.y); p[5] = bf_lo(pw.z); p[6] = bf_hi(pw.z); p[7] = bf_lo(pw.w); p[8] = bf_hi(pw.w);
    { const float hv = bf1(base[(n0 + 8 < SEQ) ? n0 + 8 : n0]); p[9] = (n0 + 8 < SEQ) ? hv : 0.f; }
#pragma unroll
    for (int e = 0; e < 8; ++e) out[e] = w0 * p[e] + w1 * p[e + 1] + w2 * p[e + 2] + bias;
}


__device__ __forceinline__ void conv8_load(const bf16_t* base, int n0, u32x4& pw, unsigned short& hl, unsigned short& hr) {
    pw = *(const u32x4*)(base + n0);
    const unsigned short hl_ = base[n0 > 0 ? n0 - 1 : 0], hr_ = base[(n0 + 8 < SEQ) ? n0 + 8 : n0];
    hl = n0 > 0 ? hl_ : (unsigned short)0;
    hr = (n0 + 8 < SEQ) ? hr_ : (unsigned short)0;
}
__device__ __forceinline__ void conv8_calc(const u32x4 pw, unsigned short hl, unsigned short hr, float w0, float w1, float w2, float bias, float (&out)[8]) {
    float p[10];
    p[0] = bf1(hl);
    p[1] = bf_lo(pw.x); p[2] = bf_hi(pw.x); p[3] = bf_lo(pw.y); p[4] = bf_hi(pw.y); p[5] = bf_lo(pw.z); p[6] = bf_hi(pw.z); p[7] = bf_lo(pw.w); p[8] = bf_hi(pw.w);
    p[9] = bf1(hr);
#pragma unroll
    for (int e = 0; e < 8; ++e) out[e] = w0 * p[e] + w1 * p[e + 1] + w2 * p[e + 2] + bias;
}
#define FRESH_LANE(v) int v; asm volatile("v_mbcnt_lo_u32_b32 %0, -1, 0\n\tv_mbcnt_hi_u32_b32 %0, -1, %0" : "=v"(v))
__device__ __forceinline__ void filter_pass(LAS unsigned char* lds, ArgP a, int l, int bx, int G, int w) {
    FRESH_LANE(lane); const int tid = w * 64 + lane;
    const float* hid = (const float*)(a->ws + WS_HID) + (size_t)l * 64 * SEQ;
    const float* w3 = a->in[I_FW3] + (size_t)l * 64 * 2048;
    bf16_t* GB = (bf16_t*)(a->ws + WS_GBUF); float* FP = (float*)(a->ws + WS_FPART);
    LAS float* wT = (LAS float*)lds;
    LAS float* wsum = (LAS float*)(lds + 64 * 68 * 4);
    for (int item = bx; item < 256; item += G) {
        const int pb = item & 7, cg = item >> 3;
        __syncthreads();
#pragma unroll
        for (int i = 0; i < 8; ++i) { const int idx = tid + 512 * i, j = idx >> 6, cc = idx & 63; wT[cc * 68 + j] = w3[(size_t)j * 2048 + 64 * cg + cc]; }
        const int p = 512 * pb + tid;
        float h[64];
#pragma unroll
        for (int j = 0; j < 64; ++j) h[j] = hid[(size_t)j * SEQ + p];
        __syncthreads();
        const float t = (float)p / 4095.0f;
        const float mind = -3.0701134573253946f, maxd = -15.350567286626973f;
        for (int cc = 0; cc < 64; ++cc) {
            const LAS f32x4* wr4 = (const LAS f32x4*)(wT + cc * 68);
            float acc = 0.f;
#pragma unroll
            for (int j4 = 0; j4 < 16; ++j4) { const f32x4 wv = wr4[j4]; acc += h[4 * j4] * wv[0]; acc += h[4 * j4 + 1] * wv[1]; acc += h[4 * j4 + 2] * wv[2]; acc += h[4 * j4 + 3] * wv[3]; }
            const int col = 64 * cg + cc, c = col & 511, dir = (col >> 9) & 1, o = col >> 10;
            const float delta = fabsf(mind + (float)c * ((maxd - mind) / 511.0f));
            const float v = acc * expf(-t * delta);
            const bool skip0 = (dir == 1) && (p == 0);
            float sq = skip0 ? 0.f : v * v;
            sq = wave_sum(sq);
            if (lane == 0) wsum[w * 64 + cc] = sq;
            if (!skip0) GB[(size_t)(o * 512 + c) * 8192 + (dir ? 4096 + p : 4096 - p)] = (bf16_t)(pk2(v, 0.f) & 0xffffu);
        }
        __syncthreads();
        if (tid < 64) { float sacc = 0.f;
#pragma unroll
            for (int ww = 0; ww < 8; ++ww) sacc += wsum[ww * 64 + tid];
            FP[(size_t)(64 * cg + tid) * 8 + pb] = sacc; }
    }
    __syncthreads();
}

template <int IG0, int IG1, bool CHECK = true>
__device__ __forceinline__ void hy_seg(LAS unsigned char* lds, f32x16 (&acc)[4], int d0, int d1, int abase, int bbase, int jbase) {
    bf16x8 A0, A1, B0[4], B1[4];
    int eight_ = 8; asm volatile("" : "+v"(eight_));
#define HY_LOAD(A, B, dd, ks) do { const int aa_ = abase - 128 * (dd) + 32 * (ks); const int ab_ = aa_ + eight_; \
        const u32x2 lo_ = *(const LAS u32x2*)(lds + aa_), hi_ = *(const LAS u32x2*)(lds + ab_); u32x4 av_; av_.x = lo_.x; av_.y = lo_.y; av_.z = hi_.x; av_.w = hi_.y; A = __builtin_bit_cast(bf16x8, av_); \
        _Pragma("unroll") for (int ig = IG0; ig < IG1; ++ig) { const int jb_ = jbase + 4 * ig - (dd); const int ba_ = (!CHECK || (unsigned)jb_ < 64u) ? (bbase + jb_ * 128 + 32 * (ks)) : HY_ZERO; B[ig] = *(const LAS bf16x8*)(lds + ba_); } } while (0)
#define HY_MMA(A, B) do { __builtin_amdgcn_s_setprio(1); _Pragma("unroll") for (int ig = IG0; ig < IG1; ++ig) acc[ig] = __builtin_amdgcn_mfma_f32_32x32x16_bf16(A, B[ig], acc[ig], 0, 0, 0); __builtin_amdgcn_s_setprio(0); } while (0)
#define HY_SB ((void)0)
    HY_LOAD(A0, B0, d0, 0);
#pragma unroll 1
    for (int d = d0; d <= d1; ++d) {
        HY_LOAD(A1, B1, d, 1); HY_SB; HY_MMA(A0, B0); HY_SB;
        HY_LOAD(A0, B0, d, 2); HY_SB; HY_MMA(A1, B1); HY_SB;
        HY_LOAD(A1, B1, d, 3); HY_SB; HY_MMA(A0, B0); HY_SB;
        HY_LOAD(A0, B0, d + 1, 0); HY_SB; HY_MMA(A1, B1); HY_SB;
    }
#undef HY_LOAD
#undef HY_MMA
#undef HY_SB
}

__device__ __forceinline__ void hyena_job(LAS unsigned char* lds, ArgP a, int l, int c, int w) {
    FRESH_LANE(lane); const int tid = w * 64 + lane, hh = lane >> 5, ql = lane & 31;
    bf16_t* PT = (bf16_t*)(a->ws + WS_PT);
    const float* cw = a->in[I_CONVW] + (size_t)l * 3 * 1536; const float* cb = a->in[I_CONVB] + (size_t)l * 1536;
    const float* skip = a->in[I_SKIP] + (size_t)l * 2 * 512;
    __syncthreads();
    if (tid < 32) ((LAS unsigned*)(lds + HY_ZERO))[tid] = 0u;
    {
        const float w0 = cw[c], w1 = cw[1536 + c], w2 = cw[3072 + c], bs = cb[c];
        const int n0 = 8 * tid;
#pragma unroll
        for (int b = 0; b < NB; ++b) {
            float o[8]; conv8(PT + (size_t)c * TT + b * SEQ, n0, w0, w1, w2, bs, o);
            u32x4 ww; ww.x = pk2(o[0], o[1]); ww.y = pk2(o[2], o[3]); ww.z = pk2(o[4], o[5]); ww.w = pk2(o[6], o[7]);
            *(LAS u32x4*)(lds + HY_UT + b * UT_STRIDE + n0 * 2) = ww;
        }
    }
    const int rhalf = w & 1, Wq = w >> 1;
    for (int o = 0; o < 2; ++o) {
        float nrm;
        {
            FRESH_LANE(lane_f); const int tid = w * 64 + lane_f;
            int zoff = 0; asm volatile("" : "+v"(zoff));
            const bf16_t* gb = (const bf16_t*)(a->ws + WS_GBUF) + (size_t)(o * 512 + c) * 8192 + zoff;
            const float* fp = (const float*)(a->ws + WS_FPART) + zoff;
            unsigned short gv[16];
#pragma unroll
            for (int k = 0; k < 16; ++k) gv[k] = gb[tid + 512 * k];
            float tot = 0.f;
#pragma unroll
            for (int pb = 0; pb < 8; ++pb) tot += fp[(size_t)(o * 1024 + c) * 8 + pb];
#pragma unroll
            for (int pb = 0; pb < 8; ++pb) tot += fp[(size_t)(o * 1024 + 512 + c) * 8 + pb];
            nrm = rsqrtf(tot + EPS); asm volatile("" : "+v"(nrm));
#pragma unroll
            for (int k = 0; k < 16; ++k) { const int t = tid + 512 * k;
#pragma unroll
                for (int sft = 0; sft < 4; ++sft) if (t - sft >= 0) *(LAS bf16_t*)(lds + HY_F + sft * COPY_STRIDE + (t - sft) * 2) = gv[k]; }
        }
        __syncthreads();
        f32x16 acc[4];
#pragma unroll
        for (int ig = 0; ig < 4; ++ig)
#pragma unroll
            for (int e = 0; e < 16; ++e) acc[ig][e] = 0.f;
        {
            FRESH_LANE(lane_m); const int hh = lane_m >> 5, ql = lane_m & 31;
            const int r = 32 * rhalf + ql;
            const int sh = (4 - (r & 3)) & 3;
            const int abase = HY_F + sh * COPY_STRIDE + (4096 - r + 8 * hh - sh) * 2;
            const int il = ql >> 3, bb = ql & 7;
            const int bbase = HY_UT + bb * UT_STRIDE + (8 * hh) * 2;
            const int jbase = 16 * Wq + il, dlo = 16 * Wq - 63;
            hy_seg<0, 1>(lds, acc, dlo, dlo + 3, abase, bbase, jbase);
            hy_seg<0, 2>(lds, acc, dlo + 4, dlo + 7, abase, bbase, jbase);
            hy_seg<0, 3>(lds, acc, dlo + 8, dlo + 11, abase, bbase, jbase);
            hy_seg<0, 4>(lds, acc, dlo + 12, 16 * Wq - 49, abase, bbase, jbase);
            hy_seg<0, 4, false>(lds, acc, 16 * Wq - 48, 16 * Wq - 1, abase, bbase, jbase);
            hy_seg<0, 4>(lds, acc, 16 * Wq, 16 * Wq + 3, abase, bbase, jbase);
            hy_seg<1, 4>(lds, acc, 16 * Wq + 4, 16 * Wq + 7, abase, bbase, jbase);
            hy_seg<2, 4>(lds, acc, 16 * Wq + 8, 16 * Wq + 11, abase, bbase, jbase);
            hy_seg<3, 4>(lds, acc, 16 * Wq + 12, 16 * Wq + 15, abase, bbase, jbase);
        }
        __syncthreads();
        {
            FRESH_LANE(lane_y); const int hh = lane_y >> 5, ql = lane_y & 31, il = ql >> 3, bb = ql & 7;
            const float sk = skip[o * 512 + c];
#pragma unroll
            for (int ig = 0; ig < 4; ++ig) {
                const int i = 16 * Wq + 4 * ig + il;
#pragma unroll
                for (int q4 = 0; q4 < 4; ++q4) {
                    const int n = 64 * i + 32 * rhalf + 8 * q4 + 4 * hh;
                    LAS u32x2* up = (LAS u32x2*)(lds + HY_UT + bb * UT_STRIDE + n * 2);
                    const u32x2 uw = *up;
                    u32x2 yw; yw.x = pk2(nrm * acc[ig][4 * q4 + 0] + sk * bf_lo(uw.x), nrm * acc[ig][4 * q4 + 1] + sk * bf_hi(uw.x));
                    yw.y = pk2(nrm * acc[ig][4 * q4 + 2] + sk * bf_lo(uw.y), nrm * acc[ig][4 * q4 + 3] + sk * bf_hi(uw.y));
                    *up = yw;
                }
            }
        }
        __syncthreads();
        {
            FRESH_LANE(lane_g); const int tid = w * 64 + lane_g;
            const int gc = 512 * (o + 1) + c;
            const float w0 = cw[gc], w1 = cw[1536 + gc], w2 = cw[3072 + gc], bs = cb[gc];
            const int n0 = 8 * tid;
            u32x4 gpw[NB]; unsigned short ghl[NB], ghr[NB];
#pragma unroll
            for (int b = 0; b < NB; ++b) conv8_load(PT + (size_t)gc * TT + b * SEQ, n0, gpw[b], ghl[b], ghr[b]);
            asm volatile("" ::: "memory");
#pragma unroll
            for (int b = 0; b < NB; ++b) {
                float x[8]; conv8_calc(gpw[b], ghl[b], ghr[b], w0, w1, w2, bs, x);
                LAS u32x4* yp = (LAS u32x4*)(lds + HY_UT + b * UT_STRIDE + n0 * 2);
                const u32x4 yw = *yp;
                u32x4 zw; zw.x = pk2(x[0] * bf_lo(yw.x), x[1] * bf_hi(yw.x)); zw.y = pk2(x[2] * bf_lo(yw.y), x[3] * bf_hi(yw.y));
                zw.z = pk2(x[4] * bf_lo(yw.z), x[5] * bf_hi(yw.z)); zw.w = pk2(x[6] * bf_lo(yw.w), x[7] * bf_hi(yw.w));
                if (o == 0) *yp = zw; else *(u32x4*)(PT + (size_t)c * TT + b * SEQ + n0) = zw;
            }
        }
        __syncthreads();
    }
}

constexpr int AT_K = 0, AT_KROW = 144, AT_VT = 384 * AT_KROW, AT_VROW = 392 * 2, AT_BT = AT_VT + 64 * AT_VROW;
static_assert(AT_BT + 132 * 4 <= LDS_BYTES, "attention LDS map");

__device__ __forceinline__ void attn_unit(LAS unsigned char* lds, ArgP a, int l, int u, int w) {
    FRESH_LANE(lane); const int tid = w * 64 + lane, hh = lane >> 5, ql = lane & 31;
    const bf16_t* QKV = (const bf16_t*)(a->ws + WS_QKV);
    bf16_t* OG = (bf16_t*)(a->ws + WS_OG); float* LSE = (float*)(a->ws + WS_LSE);
    const float* btab = (const float*)(a->ws + WS_BTAB);
    const float* qn = a->in[I_QN] + l * 64; const float* kn = a->in[I_KN] + l * 64;
    const int g = u >> 9, v = u & 511, b = v >> 6, rem = v & 63;
    const int dsh = 2 * g, m = SEQ >> dsh, nQb = m >> 8;
    const int Qb = rem % nQb, h = (rem / nQb) & 3, rho = rem / (4 * nQb);
    const int kidx0 = 256 * Qb - 64;
    const int q0 = 32 * w;
    const int qidx = 256 * Qb + q0 + ql;
    const size_t qrow = (size_t)b * SEQ + rho + ((size_t)qidx << dsh);
    u32x4 qw[4];
    { const bf16_t* qp = QKV + qrow * QKVW + g * 256 + h * 64 + 8 * hh;
#pragma unroll
      for (int ks = 0; ks < 4; ++ks) qw[ks] = *(const u32x4*)(qp + 16 * ks); }
    __syncthreads();
    {
        if (tid < 384) {
            const int kl = tid; const int idx = kidx0 + kl; const bool ok = idx >= 0 && idx < m;
            const size_t row = (size_t)b * SEQ + rho + ((size_t)(ok ? idx : 0) << dsh);
            const bf16_t* rp = QKV + row * QKVW + g * 256 + h * 64;
            u32x4 kw[8], vw[8];
#pragma unroll
            for (int c8 = 0; c8 < 8; ++c8) { kw[c8] = *(const u32x4*)(rp + 768 + 8 * c8); vw[c8] = *(const u32x4*)(rp + 1536 + 8 * c8); }
            if (!ok) {
#pragma unroll
                for (int c8 = 0; c8 < 8; ++c8) { kw[c8] = (u32x4){0u, 0u, 0u, 0u}; vw[c8] = (u32x4){0u, 0u, 0u, 0u}; }
            }
            float s = 0.f;
#pragma unroll
            for (int c8 = 0; c8 < 8; ++c8) {
                const float f[8] = {bf_lo(kw[c8].x), bf_hi(kw[c8].x), bf_lo(kw[c8].y), bf_hi(kw[c8].y), bf_lo(kw[c8].z), bf_hi(kw[c8].z), bf_lo(kw[c8].w), bf_hi(kw[c8].w)};
#pragma unroll
                for (int e = 0; e < 8; ++e) s += f[e] * f[e];
            }
            const float rs = rsqrtf(s * (1.0f / 64.0f) + EPS);
#pragma unroll
            for (int c8 = 0; c8 < 8; ++c8) {
                const float f[8] = {bf_lo(kw[c8].x), bf_hi(kw[c8].x), bf_lo(kw[c8].y), bf_hi(kw[c8].y), bf_lo(kw[c8].z), bf_hi(kw[c8].z), bf_lo(kw[c8].w), bf_hi(kw[c8].w)};
                const float* kg = kn + 8 * c8;
                u32x4 ko; ko.x = pk2(f[0] * rs * kg[0], f[1] * rs * kg[1]); ko.y = pk2(f[2] * rs * kg[2], f[3] * rs * kg[3]);
                ko.z = pk2(f[4] * rs * kg[4], f[5] * rs * kg[5]); ko.w = pk2(f[6] * rs * kg[6], f[7] * rs * kg[7]);
                *(LAS u32x4*)(lds + AT_K + kl * AT_KROW + 16 * c8) = ko;
                LAS bf16_t* vt = (LAS bf16_t*)(lds + AT_VT + (8 * c8) * AT_VROW + kl * 2);
                vt[0 * (AT_VROW / 2)] = (bf16_t)(vw[c8].x & 0xffffu); vt[1 * (AT_VROW / 2)] = (bf16_t)(vw[c8].x >> 16);
                vt[2 * (AT_VROW / 2)] = (bf16_t)(vw[c8].y & 0xffffu); vt[3 * (AT_VROW / 2)] = (bf16_t)(vw[c8].y >> 16);
                vt[4 * (AT_VROW / 2)] = (bf16_t)(vw[c8].z & 0xffffu); vt[5 * (AT_VROW / 2)] = (bf16_t)(vw[c8].z >> 16);
                vt[6 * (AT_VROW / 2)] = (bf16_t)(vw[c8].w & 0xffffu); vt[7 * (AT_VROW / 2)] = (bf16_t)(vw[c8].w >> 16);
            }
        } else if (tid < 384 + 129) {
            ((LAS float*)(lds + AT_BT))[tid - 384] = btab[(g * 4 + h) * 132 + (tid - 384)];
        }
    }
    __syncthreads();
    bf16x8 qf[4];
    {
        float s = 0.f;
#pragma unroll
        for (int ks = 0; ks < 4; ++ks) {
            const float f[8] = {bf_lo(qw[ks].x), bf_hi(qw[ks].x), bf_lo(qw[ks].y), bf_hi(qw[ks].y), bf_lo(qw[ks].z), bf_hi(qw[ks].z), bf_lo(qw[ks].w), bf_hi(qw[ks].w)};
#pragma unroll
            for (int e = 0; e < 8; ++e) s += f[e] * f[e]; }
        s += shx(s, 32);
        const float rs = rsqrtf(s * (1.0f / 64.0f) + EPS);
#pragma unroll
        for (int ks = 0; ks < 4; ++ks) {
            const float* gp = qn + 16 * ks + 8 * hh;
            const float f[8] = {bf_lo(qw[ks].x), bf_hi(qw[ks].x), bf_lo(qw[ks].y), bf_hi(qw[ks].y), bf_lo(qw[ks].z), bf_hi(qw[ks].z), bf_lo(qw[ks].w), bf_hi(qw[ks].w)};
            u32x4 o; o.x = pk2(f[0] * rs * gp[0], f[1] * rs * gp[1]); o.y = pk2(f[2] * rs * gp[2], f[3] * rs * gp[3]);
            o.z = pk2(f[4] * rs * gp[4], f[5] * rs * gp[5]); o.w = pk2(f[6] * rs * gp[6], f[7] * rs * gp[7]);
            qf[ks] = __builtin_bit_cast(bf16x8, o);
        }
    }
    f32x16 st[5];
#pragma unroll
    for (int kt = 0; kt < 5; ++kt) {
#pragma unroll
        for (int e = 0; e < 16; ++e) st[kt][e] = 0.f;
#pragma unroll
        for (int ks = 0; ks < 4; ++ks) {
            const bf16x8 kfr = *(const LAS bf16x8*)(lds + AT_K + (q0 + 32 * kt + ql) * AT_KROW + (16 * ks + 8 * hh) * 2);
            st[kt] = __builtin_amdgcn_mfma_f32_32x32x16_bf16(kfr, qf[ks], st[kt], 0, 0, 0);
        }
    }
    const LAS float* bt = (const LAS float*)(lds + AT_BT);
    float mx = -1e30f;
#pragma unroll
    for (int kt = 0; kt < 5; ++kt) {
        float bv[16];
#pragma unroll
        for (int e = 0; e < 16; ++e) {
            const int cr = (e & 3) + 8 * (e >> 2) + 4 * hh;
            int ri = 32 * kt + cr - ql; ri = ri < 0 ? 0 : (ri > 128 ? 128 : ri);
            bv[e] = bt[ri];
        }
#pragma unroll
        for (int e = 0; e < 16; ++e) {
            const int cr = (e & 3) + 8 * (e >> 2) + 4 * hh;
            const int rel = 32 * kt + cr - 64 - ql;
            const int kidx = kidx0 + q0 + 32 * kt + cr;
            const bool ok = rel >= -64 && rel <= 64 && kidx >= 0 && kidx < m;
            const float sv = st[kt][e] * 0.125f + bv[e];
            const float s = ok ? sv : -1e30f;
            st[kt][e] = s; mx = fmaxf(mx, s);
        }
    }
    mx = fmaxf(mx, shx(mx, 32));
    float den = 0.f;
#pragma unroll
    for (int kt = 0; kt < 5; ++kt)
#pragma unroll
        for (int e = 0; e < 16; ++e) { const float p = st[kt][e] > -1e29f ? __expf(st[kt][e] - mx) : 0.f; st[kt][e] = p; den += p; }
    den += shx(den, 32);
    f32x16 ot[2];
#pragma unroll
    for (int dt = 0; dt < 2; ++dt)
#pragma unroll
        for (int e = 0; e < 16; ++e) ot[dt][e] = 0.f;
#pragma unroll
    for (int kt = 0; kt < 5; ++kt)
#pragma unroll
        for (int s2 = 0; s2 < 2; ++s2) {
            u32x4 pw; pw.x = pk2(st[kt][8 * s2 + 0], st[kt][8 * s2 + 1]); pw.y = pk2(st[kt][8 * s2 + 2], st[kt][8 * s2 + 3]);
            pw.z = pk2(st[kt][8 * s2 + 4], st[kt][8 * s2 + 5]); pw.w = pk2(st[kt][8 * s2 + 6], st[kt][8 * s2 + 7]);
            const bf16x8 pb = __builtin_bit_cast(bf16x8, pw);
#pragma unroll
            for (int dt = 0; dt < 2; ++dt) {
                const int va = AT_VT + (32 * dt + ql) * AT_VROW + (q0 + 32 * kt + 16 * s2 + 4 * hh) * 2;
                const u32x2 lo = *(const LAS u32x2*)(lds + va), hi = *(const LAS u32x2*)(lds + va + 16);
                u32x4 av; av.x = lo.x; av.y = lo.y; av.z = hi.x; av.w = hi.y;
                ot[dt] = __builtin_amdgcn_mfma_f32_32x32x16_bf16(__builtin_bit_cast(bf16x8, av), pb, ot[dt], 0, 0, 0);
            }
        }
    const float inv = 1.0f / den;
    bf16_t* op = OG + ((size_t)g * TT + qrow) * 256 + h * 64;
#pragma unroll
    for (int dt = 0; dt < 2; ++dt)
#pragma unroll
        for (int q4 = 0; q4 < 4; ++q4) {
            u32x2 ow; ow.x = pk2(ot[dt][4 * q4 + 0] * inv, ot[dt][4 * q4 + 1] * inv); ow.y = pk2(ot[dt][4 * q4 + 2] * inv, ot[dt][4 * q4 + 3] * inv);
            *(u32x2*)(op + 32 * dt + 8 * q4 + 4 * hh) = ow;
        }
    if (hh == 0) LSE[((size_t)g * TT + qrow) * 4 + h] = mx + __logf(den);
}

__device__ __forceinline__ void trans_combine(LAS unsigned char* lds, ArgP a, int tid, int bx, int G) {
    const bf16_t* PT = (const bf16_t*)(a->ws + WS_PT); bf16_t* YHY = (bf16_t*)(a->ws + WS_YHY);
    const bf16_t* __restrict__ OG = (const bf16_t*)(a->ws + WS_OG); const float* __restrict__ LSE = (const float*)(a->ws + WS_LSE); bf16_t* __restrict__ YAT = (bf16_t*)(a->ws + WS_YAT);
    constexpr int TROW = 72 * 2;
    {
        const int lane = tid & 63, wv = tid >> 6;
        LAS unsigned char* tl = lds + wv * (64 * TROW);
        for (int tile = bx * 8 + wv; tile < 8 * 512; tile += G * 8) {
            const int cb = tile & 7, tb = tile >> 3, c8 = lane & 7;
            u32x4 v[8];
#pragma unroll
            for (int it = 0; it < 8; ++it) { const int ch = (lane >> 3) + 8 * it; v[it] = *(const u32x4*)(PT + (size_t)(64 * cb + ch) * TT + 64 * tb + 8 * c8); }
#pragma unroll
            for (int it = 0; it < 8; ++it) { const int ch = (lane >> 3) + 8 * it; *(LAS u32x4*)(tl + ch * TROW + 16 * c8) = v[it]; }
#pragma unroll
            for (int it = 0; it < 8; ++it) { const int tok = (lane >> 3) + 8 * it;
                const LAS bf16_t* sp = (const LAS bf16_t*)(tl + (8 * c8) * TROW + tok * 2);
                unsigned e[8];
#pragma unroll
                for (int k = 0; k < 8; ++k) e[k] = sp[k * (TROW / 2)];
                u32x4 o; o.x = e[0] | (e[1] << 16); o.y = e[2] | (e[3] << 16); o.z = e[4] | (e[5] << 16); o.w = e[6] | (e[7] << 16);
                *(u32x4*)(YHY + (size_t)(64 * tb + tok) * 512 + 64 * cb + 8 * c8) = o; }
        }
    }
#pragma unroll 4
    for (size_t i = (size_t)bx * 512 + tid; i < (size_t)TT * 32; i += (size_t)G * 512) {
        const size_t row = i >> 5; const int c8 = (int)(i & 31), h = c8 >> 3;
        const float l0 = LSE[(0 * (size_t)TT + row) * 4 + h], l1 = LSE[(1 * (size_t)TT + row) * 4 + h], l2 = LSE[(2 * (size_t)TT + row) * 4 + h];
        const float mxl = fmaxf(l0, fmaxf(l1, l2));
        float e0 = __expf(l0 - mxl), e1 = __expf(l1 - mxl), e2 = __expf(l2 - mxl);
        const float inv = 1.0f / (e0 + e1 + e2); e0 *= inv; e1 *= inv; e2 *= inv;
        const u32x4 a0 = *(const u32x4*)(OG + (0 * (size_t)TT + row) * 256 + 8 * c8), a1 = *(const u32x4*)(OG + (1 * (size_t)TT + row) * 256 + 8 * c8),
                    a2 = *(const u32x4*)(OG + (2 * (size_t)TT + row) * 256 + 8 * c8);
        u32x4 o;
        o.x = pk2(e0 * bf_lo(a0.x) + e1 * bf_lo(a1.x) + e2 * bf_lo(a2.x), e0 * bf_hi(a0.x) + e1 * bf_hi(a1.x) + e2 * bf_hi(a2.x));
        o.y = pk2(e0 * bf_lo(a0.y) + e1 * bf_lo(a1.y) + e2 * bf_lo(a2.y), e0 * bf_hi(a0.y) + e1 * bf_hi(a1.y) + e2 * bf_hi(a2.y));
        o.z = pk2(e0 * bf_lo(a0.z) + e1 * bf_lo(a1.z) + e2 * bf_lo(a2.z), e0 * bf_hi(a0.z) + e1 * bf_hi(a1.z) + e2 * bf_hi(a2.z));
        o.w = pk2(e0 * bf_lo(a0.w) + e1 * bf_lo(a1.w) + e2 * bf_lo(a2.w), e0 * bf_hi(a0.w) + e1 * bf_hi(a1.w) + e2 * bf_hi(a2.w));
        *(u32x4*)(YAT + row * 256 + 8 * c8) = o;
    }
}


#define XB_TMO      128
#define XB_XCNT(j)  (256  + 64 * (j))
#define XB_XSUB(j)  (1280 + 64 * (j))
#define XB_XGEN(j)  (2304 + 64 * (j))
#define XB_TOP      3328
#define XB_TOPGEN   3392
#define XCD_BAR_WORDS 3456
#define XB_SPIN_CAP (1u << 22)
__device__ __forceinline__ unsigned xb_ld(unsigned* p)              { return __hip_atomic_load(p, __ATOMIC_RELAXED, __HIP_MEMORY_SCOPE_AGENT); }
__device__ __forceinline__ unsigned xb_add(unsigned* p, unsigned v) { return __hip_atomic_fetch_add(p, v, __ATOMIC_RELAXED, __HIP_MEMORY_SCOPE_AGENT); }
__device__ __forceinline__ unsigned xb_xcc_id() { return (unsigned)__builtin_amdgcn_s_getreg((3 << 11) | 20) & 0xFu; }
#define XB_SPIN(cond, bar) do { unsigned _sp = 0; while (cond) { __builtin_amdgcn_s_sleep(1); \
    if ((++_sp & 255u) == 0u) { if (xb_ld(&(bar)[XB_TMO])) break; if (_sp > XB_SPIN_CAP) { atomicAdd(&(bar)[XB_TMO], 1u); break; } } } } while (0)
__device__ __forceinline__ void xcd_barrier_complete(unsigned* bar, unsigned x, unsigned& nloc, unsigned& nx) {
    const unsigned G = gridDim.x * gridDim.y * gridDim.z;
    unsigned sum, cnt, mine, sp = 0u;
    for (;;) {
        sum = 0u; cnt = 0u; mine = 0u;
#pragma unroll
        for (unsigned j = 0; j < 16; ++j) { const unsigned c = xb_ld(&bar[XB_XCNT(j)]); sum += c; cnt += (c > 0u) ? 1u : 0u; mine = (j == x) ? c : mine; }
        if (sum == G) break;
        __builtin_amdgcn_s_sleep(1);
        if ((++sp & 255u) == 0u) { if (xb_ld(&bar[XB_TMO])) break; if (sp > XB_SPIN_CAP) { atomicAdd(&bar[XB_TMO], 1u); break; } }
    }
    nloc = mine > 0u ? mine : 1u; nx = cnt > 0u ? cnt : 1u;
}
__device__ __forceinline__ void xcd_barrier(unsigned* bar, volatile LAS unsigned* st) {
    asm volatile("s_waitcnt vmcnt(0)" ::: "memory");
    __syncthreads();
    if (threadIdx.x == 0) {
        __builtin_amdgcn_s_waitcnt(0);
        const unsigned x = xb_xcc_id();
        unsigned nloc = st[0], nx = st[1];
        if (nloc == 0u) { xcd_barrier_complete(bar, x, nloc, nx); st[0] = nloc; st[1] = nx; }
        const unsigned old = xb_add(&bar[XB_XSUB(x)], 1u);
        const unsigned gen = old / nloc;
        if (old + 1u == (gen + 1u) * nloc) {
            __builtin_amdgcn_fence(__ATOMIC_RELEASE, "agent");
            asm volatile("s_waitcnt vmcnt(0)" ::: "memory");
            const unsigned og = xb_add(&bar[XB_TOP], 1u);
            const unsigned tg = og / nx;
            if (og + 1u == (tg + 1u) * nx) xb_add(&bar[XB_TOPGEN], 1u);
            else XB_SPIN(xb_ld(&bar[XB_TOPGEN]) == tg, bar);
            __builtin_amdgcn_fence(__ATOMIC_ACQUIRE, "agent");
            xb_add(&bar[XB_XGEN(x)], 1u);
            asm volatile("s_waitcnt vmcnt(0)" ::: "memory");
        } else {
            XB_SPIN(xb_ld(&bar[XB_XGEN(x)]) == gen, bar);
            __builtin_amdgcn_fence(__ATOMIC_ACQUIRE, "agent");
            asm volatile("s_waitcnt vmcnt(0)" ::: "memory");
        }
    }
    __syncthreads();
}

constexpr int N_PHASES = 1 + 9 * NLAYER;
#define PHASE_IDS \
    int lane; asm volatile("v_mbcnt_lo_u32_b32 %0, -1, 0\n\tv_mbcnt_hi_u32_b32 %0, -1, %0" : "=v"(lane)); \
    int G = gridDim.x, bx = blockIdx.x, wave = wave0; asm volatile("" : "+s"(G), "+s"(bx), "+s"(wave)); \
    const int tid = wave * 64 + lane; const int gw = bx * 8 + wave, ngw = G * 8; (void)gw; (void)ngw; (void)tid;
__global__ void __launch_bounds__(512, 2) hybrid_fwd(Args args_unused) {
    extern __shared__ __attribute__((aligned(16))) unsigned char lds_raw[];
    LAS unsigned char* lds = (LAS unsigned char*)lds_raw;
    cg::grid_group grid = cg::this_grid();
    const int wave0 = __builtin_amdgcn_readfirstlane(threadIdx.x >> 6);
    ArgP ap0 = (ArgP)__builtin_amdgcn_kernarg_segment_ptr();
    const int ph_lo = ap0->ph_lo, ph_hi = ap0->ph_hi;
    if (threadIdx.x < 16) ((LAS unsigned*)(lds + LDS_MISC))[threadIdx.x] = 0u;
    if (threadIdx.x == 0 && ph_hi - ph_lo > 1) (void)xb_add((unsigned*)(ap0->ws + WS_BAR) + XB_XCNT(xb_xcc_id()), 1u);
    __syncthreads();
#define WPTR(off) ((const bf16_t*)((const char*)Wb + (off)))
    for (int ph = ph_lo; ph < ph_hi; ++ph) {
        ArgP args = ap0; asm volatile("" : "+s"(args));
        unsigned char* ws = args->ws;
        float* ssq = (float*)(ws + WS_SSQ);
        bf16_t* XB = (bf16_t*)(ws + WS_XB);
        bf16_t* Hb = (bf16_t*)(ws + WS_H);
        const bf16_t* Wb = (const bf16_t*)(ws + WS_W);
        if (ph == 0) {
            PHASE_IDS
            prologue(args, lds, gw, ngw, wave, lane);
        } else {
            const int l = (ph - 1) / 9, k = (ph - 1) % 9;
            if (k == 0 || k == 7) {
                PHASE_IDS
                const int which = (k == 7);
                pg8::Gemm g{XB, WPTR(which ? W_UP2 : W_UP1), TT, 2 * DFF, DM};
                pg8::StaticOrder S; S.init(TT, 2 * DFF, G, bx);
                int rsbase = 0; const LAS float* rstab = build_rstd_table(lds, S, ssq, tid, rsbase);
                pg8::EpiFfnUp E{Hb, ssq, rstab, rsbase};
                pg8::gemm_phase<pg8::EpiFfnUp, pg8::StaticOrder>(lds, g, S, E, tid);
            } else if (k == 1 || k == 8 || k == 6) {
                PHASE_IDS
                if (k == 1) filter_pass(lds, args, l, bx, G, wave);
                const bool isout = (k == 6);
                pg8::Gemm g{isout ? (const bf16_t*)(ws + WS_Y) : Hb, WPTR(k == 1 ? W_DN1 : (k == 8 ? W_DN2 : W_OUT)), TT, DM, isout ? DM : DFF};
                pg8::StaticOrder S; S.init(TT, DM, G, bx);
                const float* xin = (l == 0 && k == 1) ? args->in[I_X] : args->out;
                const bool lastp = (l == NLAYER - 1 && k == 8);
                pg8::EpiResid E{xin, args->out, XB, lastp ? nullptr : ssq, isout ? 1.0f : 0.5f};
                pg8::gemm_phase<pg8::EpiResid, pg8::StaticOrder>(lds, g, S, E, tid);
            } else if (k == 2) {
                PHASE_IDS
                pg8::Gemm g{XB, WPTR(W_IN), TT, INW + GATEW, DM};
                pg8::StaticOrder S; S.init(TT, INW + GATEW, G, bx);
                int rsbase = 0; const LAS float* rstab = build_rstd_table(lds, S, ssq, tid, rsbase);
                pg8::EpiWin E{(bf16_t*)(ws + WS_PT), (bf16_t*)(ws + WS_QKV), (bf16_t*)(ws + WS_G), ssq, args->in[I_BGATE] + (size_t)l * GATEW, rstab, rsbase};
                pg8::gemm_phase<pg8::EpiWin, pg8::StaticOrder>(lds, g, S, E, tid);
            } else if (k == 3) {
                PHASE_IDS
                #ifndef NO_HY
                for (int c = bx; c < HYW; c += G) hyena_job(lds, args, l, c, wave);
#endif
                #ifndef NO_AT
                for (int u = bx; u < 1536; u += G) attn_unit(lds, args, l, u, wave);
#endif
            } else if (k == 4) {
                PHASE_IDS
                trans_combine(lds, args, tid, bx, G);
                __syncthreads();
                if (l == 0) convert_weights(args, 1, 1, lds, gw, ngw, wave, lane);
                else convert_weights(args, 1, 2, lds, gw, ngw, wave, lane);
            } else if (k == 5) {
                PHASE_IDS
                pg8::StaticOrder S; S.init(TT, DM, G, bx);
                { pg8::Gemm g{(const bf16_t*)(ws + WS_YHY), WPTR(W_HY), TT, DM, 512};
                  pg8::EpiMerge<false> E{(bf16_t*)(ws + WS_Y), (const bf16_t*)(ws + WS_G), 0};
                  pg8::gemm_phase<pg8::EpiMerge<false>, pg8::StaticOrder>(lds, g, S, E, tid); }
                { pg8::Gemm g{(const bf16_t*)(ws + WS_YAT), WPTR(W_AT), TT, DM, 256};
                  pg8::EpiMerge<true> E{(bf16_t*)(ws + WS_Y), (const bf16_t*)(ws + WS_G), DM};
                  pg8::gemm_phase<pg8::EpiMerge<true>, pg8::StaticOrder>(lds, g, S, E, tid); }
            }
        }
        if (ph + 1 < ph_hi) {
            if (ph_hi > 1000000) grid.sync();
            { ArgP ab = ap0; asm volatile("" : "+s"(ab)); xcd_barrier((unsigned*)(ab->ws + WS_BAR), (volatile LAS unsigned*)(lds + LDS_MISC)); }
        }
    }
#undef WPTR
}

#ifndef N_LAUNCH_PER_PHASE
#define N_LAUNCH_PER_PHASE 0
#endif
extern "C" void kernel_launch(void* const* d_in, const int* in_sizes, int n_in, void* d_out, int out_size, void* d_ws, size_t ws_size, hipStream_t stream) {
    static int grid = 0;
    if (grid == 0) {
        if (n_in != 27 || in_sizes[0] != TT * DM || out_size != TT * DM || ws_size < WS_END) {
            fprintf(stderr, "kernel_launch: unexpected shapes: n_in %d in0 %d out %d ws %zu (need %zu)\n", n_in, n_in > 0 ? in_sizes[0] : -1, out_size, ws_size, (size_t)WS_END);
            grid = -1; return; }
        int dev = 0, cus = 0, per_cu = 0;
        hipGetDevice(&dev); hipDeviceGetAttribute(&cus, hipDeviceAttributeMultiprocessorCount, dev);
        hipFuncSetAttribute((const void*)hybrid_fwd, hipFuncAttributeMaxDynamicSharedMemorySize, LDS_BYTES);
        hipOccupancyMaxActiveBlocksPerMultiprocessor(&per_cu, (const void*)hybrid_fwd, 512, LDS_BYTES);
        (void)hipGetLastError();
        if (per_cu < 1) { fprintf(stderr, "kernel_launch: occupancy query says %d blocks/CU\n", per_cu); }
        grid = cus > 0 ? cus : 256;
    }
    if (grid < 0) return;
    Args a{};
    for (int i = 0; i < 27; ++i) a.in[i] = (const float*)d_in[i];
    a.out = (float*)d_out; a.ws = (unsigned char*)d_ws;
#if N_LAUNCH_PER_PHASE
    for (int ph = 0; ph < N_PHASES; ++ph) {
        a.ph_lo = ph; a.ph_hi = ph + 1;
        hipLaunchKernelGGL(hybrid_fwd, dim3(grid), dim3(512), LDS_BYTES, stream, a);
    }
#else
    a.ph_lo = 0; a.ph_hi = N_PHASES;
    (void)hipMemsetAsync((char*)d_ws + WS_BAR, 0, 16384, stream);
    void* kargs[] = {&a};
    hipError_t e = hipLaunchCooperativeKernel((const void*)hybrid_fwd, dim3(grid), dim3(512), kargs, LDS_BYTES, stream);
    if (e != hipSuccess) fprintf(stderr, "cooperative launch failed: %s (grid %d)\n", hipGetErrorString(e), grid);
#endif
}
```

```cpp
#include <hip/hip_runtime.h>
#include <hip/hip_cooperative_groups.h>
#include <cstdio>
#include <cstdint>
namespace cg = cooperative_groups;

#define LAS __attribute__((address_space(3)))
typedef unsigned short bf16_t;
typedef short bf16x8 __attribute__((ext_vector_type(8)));
typedef float f32x4 __attribute__((ext_vector_type(4)));
typedef float f32x16 __attribute__((ext_vector_type(16)));
typedef unsigned u32x4 __attribute__((ext_vector_type(4)));
typedef unsigned u32x2 __attribute__((ext_vector_type(2)));

constexpr int DM = 1024, NB = 8, SEQ = 4096, TT = NB * SEQ, DFF = 2688, NLAYER = 2;
constexpr int HYW = 512, INW = 3840, QKVW = 2304, GATEW = 2048;
constexpr float EPS = 1e-6f;

constexpr size_t MiB = 1u << 20;
constexpr size_t WS_SSQ = 0;
constexpr size_t WS_HID = 2 * MiB;
constexpr size_t WS_BTAB = 4 * MiB;
constexpr size_t WS_BAR = 4 * MiB + 65536;
constexpr size_t WS_FPART = 4 * MiB + 524288;
constexpr size_t WS_W = 5 * MiB;
constexpr size_t W_UP1 = 0, W_DN1 = W_UP1 + (size_t)2 * DFF * DM * 2, W_IN = W_DN1 + (size_t)DM * DFF * 2,
                 W_HY = W_IN + (size_t)(INW + GATEW) * DM * 2, W_AT = W_HY + (size_t)DM * 512 * 2, W_OUT = W_AT + (size_t)DM * 256 * 2,
                 W_UP2 = W_OUT + (size_t)DM * DM * 2, W_DN2 = W_UP2 + (size_t)2 * DFF * DM * 2, W_END = W_DN2 + (size_t)DM * DFF * 2;
static_assert(W_END <= 47 * MiB, "weights region");
constexpr size_t WS_XB = 52 * MiB;
constexpr size_t WS_OG = WS_XB;
constexpr size_t WS_LSE = WS_XB + 48 * MiB;
constexpr size_t WS_BIG = 116 * MiB;
constexpr size_t WS_H = WS_BIG;
constexpr size_t WS_PT = WS_BIG;
constexpr size_t WS_QKV = WS_BIG + 96 * MiB;
constexpr size_t WS_G = WS_QKV + 144 * MiB;
constexpr size_t WS_YHY = WS_QKV;
constexpr size_t WS_YAT = WS_QKV + 32 * MiB;
constexpr size_t WS_Y = WS_QKV + 48 * MiB;
constexpr size_t WS_GBUF = WS_G + 128 * MiB;
constexpr size_t WS_END = WS_GBUF + 16 * MiB;

constexpr int LDS_RS = 131072, LDS_MISC = LDS_RS + 16384, LDS_BYTES = LDS_MISC + 1024;

__device__ __forceinline__ unsigned pk2(float lo, float hi) {
    typedef float f2 __attribute__((ext_vector_type(2))); typedef __bf16 b2 __attribute__((ext_vector_type(2)));
    f2 v = {lo, hi}; b2 b = __builtin_convertvector(v, b2); return __builtin_bit_cast(unsigned, b);
}
__device__ __forceinline__ float bf_lo(unsigned w) { return __uint_as_float(w << 16); }
__device__ __forceinline__ float bf_hi(unsigned w) { return __uint_as_float(w & 0xffff0000u); }
__device__ __forceinline__ float bf1(bf16_t h) { return __uint_as_float(((unsigned)h) << 16); }
__device__ __forceinline__ float shx(float v, int mask) {
    int l; asm volatile("v_mbcnt_lo_u32_b32 %0, -1, 0\n\tv_mbcnt_hi_u32_b32 %0, -1, %0" : "=v"(l));
    return __int_as_float(__builtin_amdgcn_ds_bpermute((l ^ mask) << 2, __float_as_int(v)));
}
__device__ __forceinline__ float wave_sum(float v) {
#define WS_DPP(x, ctrl, rmask) __int_as_float(__builtin_amdgcn_update_dpp(0, __float_as_int(x), ctrl, rmask, 0xF, false))
    v += WS_DPP(v, 0xB1, 0xF);
    v += WS_DPP(v, 0x4E, 0xF);
    v += WS_DPP(v, 0x141, 0xF);
    v += WS_DPP(v, 0x140, 0xF);
    v += WS_DPP(v, 0x142, 0xA);
    v += WS_DPP(v, 0x143, 0xC);
#undef WS_DPP
    return __int_as_float(__builtin_amdgcn_readlane(__float_as_int(v), 63));
}
__device__ __forceinline__ float sigmoidf_(float x) { return __builtin_amdgcn_rcpf(1.f + __builtin_amdgcn_exp2f(x * -1.4426950408889634f)); }
__device__ __forceinline__ float row_rstd_q(const float* part, int row, int fq) {
    const f32x4 a = *(const f32x4*)(part + (size_t)row * 16 + 4 * fq);
    float s = (a[0] + a[1]) + (a[2] + a[3]);
    s += shx(s, 16); s += shx(s, 32);
    return rsqrtf(s * (1.0f / 1024.0f) + 1e-6f);
}
__device__ __forceinline__ float row_rstd(const float* part, int row) {
    const f32x4* p = (const f32x4*)(part + (size_t)row * 16);
    const f32x4 a = p[0], b = p[1], c = p[2], d = p[3];
    const float s = ((a[0] + a[1]) + (a[2] + a[3])) + ((b[0] + b[1]) + (b[2] + b[3])) + ((c[0] + c[1]) + (c[2] + c[3])) + ((d[0] + d[1]) + (d[2] + d[3]));
    return rsqrtf(s * (1.0f / 1024.0f) + 1e-6f);
}

namespace pg8 {
constexpr int BM = 256, BK = 64, HALF = 128, HTB = HALF * BK * 2, STAGE_BYTES = 8 * HTB, NXCD = 8, WGM = 8;
__host__ __device__ __forceinline__ int lds_byte(int r, int c) { const int st = (r >> 4) * 2 + (c >> 5), rr = r & 15, cc = c & 31, ob = rr * 64 + cc * 2; return st * 1024 + (ob ^ (((ob >> 9) & 1) << 5)); }
__host__ __device__ __forceinline__ void stage_rc(int b, int& R, int& C) { const int st = b / 1024, sb = b % 1024, swz = sb ^ (((sb >> 9) & 1) << 5); R = (st >> 1) * 16 + swz / 64; C = (st & 1) * 32 + (swz % 64) / 2; }
__host__ __device__ __forceinline__ int perm32(int rho) { const int n = rho >> 4, i = rho & 15; return 8 * (i >> 2) + 4 * n + (i & 3); }

struct Unit { int pm, pn; };
struct Gemm { const bf16_t* A; const bf16_t* Bt; int M, N, K; };

struct StaticOrder {
    int nM, nN, nwg, G, c;
    __device__ void init(int M, int N, int G_, int c_) { nM = M / BM; nN = N / BM; nwg = nM * nN; G = G_; c = c_; }
    __device__ bool next(int i, Unit& u) const {
        const long L = (long)i * G + c; if (L >= nwg) return false;
        int wgid = (int)L; { const int q = nwg / NXCD, r = nwg % NXCD, xcd = wgid % NXCD, off = wgid / NXCD; wgid = (xcd < r ? xcd * (q + 1) : r * (q + 1) + (xcd - r) * q) + off; }
        const int nig = WGM * nN, gid = wgid / nig, fm = gid * WGM, gsz = (nM - fm) < WGM ? (nM - fm) : WGM;
        u.pm = fm + ((wgid % nig) % gsz); u.pn = (wgid % nig) / gsz; return true;
    }
    __device__ __forceinline__ void a_ready(const Unit&) const {}
    __device__ __forceinline__ void done(const Unit&) const {}
};


struct EpiFfnUp {
    static constexpr bool PERM = true;
    bf16_t* H; const float* ssq; const LAS float* rstab; int rsbase;
    __device__ __forceinline__ void operator()(const f32x4 (&acc)[2][2][4][2], const Unit& u, int wr, int wc, int fr, int fq) const {
        const int row0 = u.pm * BM + wr * 64 + fr, col0 = u.pn * 128 + wc * 32 + 8 * fq;
#pragma unroll
        for (int ai = 0; ai < 2; ++ai)
#pragma unroll
            for (int m = 0; m < 4; ++m) {
                const int row = row0 + ai * HALF + m * 16;
                const float rs = rstab ? rstab[row - rsbase] : row_rstd_q(ssq, row, fq);
                float h[8];
#pragma unroll
                for (int n = 0; n < 2; ++n)
#pragma unroll
                    for (int e = 0; e < 4; ++e) { const float g = acc[ai][0][m][n][e] * rs, up = acc[ai][1][m][n][e] * rs; h[n * 4 + e] = g * sigmoidf_(g) * up; }
                u32x4 w; w.x = pk2(h[0], h[1]); w.y = pk2(h[2], h[3]); w.z = pk2(h[4], h[5]); w.w = pk2(h[6], h[7]);
                *(u32x4*)(H + (size_t)row * DFF + col0) = w;
            }
    }
};
struct EpiResid {
    static constexpr bool PERM = false;
    const float* Xin; float* Xout; bf16_t* XB; float* ssq; float alpha;
    __device__ __forceinline__ void ldb(f32x4 (&xi)[2][2][2], int row0, int col0, int bt) const {
        const int ai = bt >> 1, mh = bt & 1;
#pragma unroll
        for (int mm = 0; mm < 2; ++mm)
#pragma unroll
            for (int bj = 0; bj < 2; ++bj)
#pragma unroll
                for (int n = 0; n < 2; ++n) xi[mm][bj][n] = *(const f32x4*)(Xin + (size_t)(row0 + ai * HALF + (2 * mh + mm) * 16) * DM + col0 + bj * HALF + n * 16);
    }
    __device__ __forceinline__ void stb(const f32x4 (&xi)[2][2][2], const f32x4 (&acc)[2][2][4][2], const Unit& u, int wc, int fq, int row0, int col0, int bt) const {
        const int ai = bt >> 1, mh = bt & 1;
#pragma unroll
        for (int mm = 0; mm < 2; ++mm) {
            const int m = 2 * mh + mm, row = row0 + ai * HALF + m * 16; float s = 0.f;
#pragma unroll
            for (int bj = 0; bj < 2; ++bj)
#pragma unroll
                for (int n = 0; n < 2; ++n) {
                    const size_t off = (size_t)row * DM + col0 + bj * HALF + n * 16;
                    const f32x4 v = xi[mm][bj][n] + acc[ai][bj][m][n] * alpha;
                    *(f32x4*)(Xout + off) = v;
                    u32x2 w; w.x = pk2(v[0], v[1]); w.y = pk2(v[2], v[3]);
                    *(u32x2*)(XB + off) = w;
                    s += (v[0] * v[0] + v[1] * v[1]) + (v[2] * v[2] + v[3] * v[3]);
                }
            if (ssq) { s += shx(s, 16); s += shx(s, 32); if (fq == 0) ssq[(size_t)row * 16 + u.pn * 4 + wc] = s; }
        }
    }
    __device__ __forceinline__ void operator()(const f32x4 (&acc)[2][2][4][2], const Unit& u, int wr, int wc, int fr, int fq) const {
        const int row0 = u.pm * BM + wr * 64 + fr, col0 = u.pn * BM + wc * 32 + 4 * fq;
        f32x4 xa[2][2][2], xb[2][2][2];
        ldb(xa, row0, col0, 0); ldb(xb, row0, col0, 1);
        asm volatile("" ::: "memory");
        stb(xa, acc, u, wc, fq, row0, col0, 0); ldb(xa, row0, col0, 2);
        asm volatile("" ::: "memory");
        stb(xb, acc, u, wc, fq, row0, col0, 1); ldb(xb, row0, col0, 3);
        asm volatile("" ::: "memory");
        stb(xa, acc, u, wc, fq, row0, col0, 2);
        asm volatile("" ::: "memory");
        stb(xb, acc, u, wc, fq, row0, col0, 3);
    }
};
struct EpiWin {
    static constexpr bool PERM = true;
    bf16_t* PT; bf16_t* QKV; bf16_t* G; const float* ssq; const float* bgate; const LAS float* rstab; int rsbase;
    __device__ __forceinline__ void operator()(const f32x4 (&acc)[2][2][4][2], const Unit& u, int wr, int wc, int fr, int fq) const {
        const int row0 = u.pm * BM + wr * 64 + fr, colt = u.pn * BM + wc * 32 + 8 * fq;
        if (u.pn < 6) {
            const bool odd = fr & 1;
#pragma unroll
            for (int ai = 0; ai < 2; ++ai)
#pragma unroll
                for (int m = 0; m < 4; ++m) {
                    const int row = row0 + ai * HALF + m * 16;
                    const float rs = rstab ? rstab[row - rsbase] : row_rstd_q(ssq, row, fq);
                    const int rowp = row & ~1;
#pragma unroll
                    for (int bj = 0; bj < 2; ++bj)
#pragma unroll
                        for (int n = 0; n < 2; ++n) {
                            const f32x4 v = acc[ai][bj][m][n] * rs;
                            const float s0 = odd ? v[0] : v[2], s1 = odd ? v[1] : v[3];
                            const float r0 = shx(s0, 1), r1 = shx(s1, 1);
                            const float k0 = odd ? v[2] : v[0], k1 = odd ? v[3] : v[1];
                            const int col = colt + bj * HALF + 4 * n + (odd ? 2 : 0);
                            const unsigned w0 = odd ? pk2(r0, k0) : pk2(k0, r0), w1 = odd ? pk2(r1, k1) : pk2(k1, r1);
                            *(unsigned*)(PT + (size_t)col * TT + rowp) = w0;
                            *(unsigned*)(PT + (size_t)(col + 1) * TT + rowp) = w1;
                        }
                }
        } else if (u.pn < 15) {
#pragma unroll
            for (int ai = 0; ai < 2; ++ai)
#pragma unroll
                for (int m = 0; m < 4; ++m) {
                    const int row = row0 + ai * HALF + m * 16;
                    const float rs = rstab ? rstab[row - rsbase] : row_rstd_q(ssq, row, fq);
#pragma unroll
                    for (int bj = 0; bj < 2; ++bj) {
                        const f32x4 v0 = acc[ai][bj][m][0] * rs, v1 = acc[ai][bj][m][1] * rs;
                        u32x4 w; w.x = pk2(v0[0], v0[1]); w.y = pk2(v0[2], v0[3]); w.z = pk2(v1[0], v1[1]); w.w = pk2(v1[2], v1[3]);
                        *(u32x4*)(QKV + (size_t)row * QKVW + (colt - 1536 + bj * HALF)) = w;
                    }
                }
        } else {
            f32x4 bv[2][2];
#pragma unroll
            for (int bj = 0; bj < 2; ++bj)
#pragma unroll
                for (int n = 0; n < 2; ++n) bv[bj][n] = *(const f32x4*)(bgate + (colt - INW + bj * HALF + 4 * n));
#pragma unroll
            for (int ai = 0; ai < 2; ++ai)
#pragma unroll
                for (int m = 0; m < 4; ++m) {
                    const int row = row0 + ai * HALF + m * 16;
                    const float rs = rstab ? rstab[row - rsbase] : row_rstd_q(ssq, row, fq);
#pragma unroll
                    for (int bj = 0; bj < 2; ++bj) {
                        const f32x4 v0 = acc[ai][bj][m][0] * rs + bv[bj][0], v1 = acc[ai][bj][m][1] * rs + bv[bj][1];
                        u32x4 w; w.x = pk2(sigmoidf_(v0[0]), sigmoidf_(v0[1])); w.y = pk2(sigmoidf_(v0[2]), sigmoidf_(v0[3]));
                        w.z = pk2(sigmoidf_(v1[0]), sigmoidf_(v1[1])); w.w = pk2(sigmoidf_(v1[2]), sigmoidf_(v1[3]));
                        *(u32x4*)(G + (size_t)row * GATEW + (colt - INW + bj * HALF)) = w;
                    }
                }
        }
    }
};
template <bool ADD> struct EpiMerge {
    static constexpr bool PERM = true;
    bf16_t* Y; const bf16_t* G; int goff;
    __device__ __forceinline__ void operator()(const f32x4 (&acc)[2][2][4][2], const Unit& u, int wr, int wc, int fr, int fq) const {
        const int row0 = u.pm * BM + wr * 64 + fr, colt = u.pn * BM + wc * 32 + 8 * fq;
#pragma unroll
        for (int ai = 0; ai < 2; ++ai)
#pragma unroll
            for (int m = 0; m < 4; ++m) {
                const int row = row0 + ai * HALF + m * 16;
#pragma unroll
                for (int bj = 0; bj < 2; ++bj) {
                    const int col = colt + bj * HALF;
                    const u32x4 gw = *(const u32x4*)(G + (size_t)row * GATEW + goff + col);
                    const f32x4 a0 = acc[ai][bj][m][0], a1 = acc[ai][bj][m][1];
                    float o[8];
                    o[0] = bf_lo(gw.x) * a0[0]; o[1] = bf_hi(gw.x) * a0[1]; o[2] = bf_lo(gw.y) * a0[2]; o[3] = bf_hi(gw.y) * a0[3];
                    o[4] = bf_lo(gw.z) * a1[0]; o[5] = bf_hi(gw.z) * a1[1]; o[6] = bf_lo(gw.w) * a1[2]; o[7] = bf_hi(gw.w) * a1[3];
                    u32x4* yp = (u32x4*)(Y + (size_t)row * DM + col);
                    if (ADD) { const u32x4 yw = *yp;
                        o[0] += bf_lo(yw.x); o[1] += bf_hi(yw.x); o[2] += bf_lo(yw.y); o[3] += bf_hi(yw.y);
                        o[4] += bf_lo(yw.z); o[5] += bf_hi(yw.z); o[6] += bf_lo(yw.w); o[7] += bf_hi(yw.w); }
                    u32x4 w; w.x = pk2(o[0], o[1]); w.y = pk2(o[2], o[3]); w.z = pk2(o[4], o[5]); w.w = pk2(o[6], o[7]);
                    *yp = w;
                }
            }
    }
};

template <class Epi, class Sched, bool ALIGN_EPI = true, bool SP2 = true>
__device__ __forceinline__ void gemm_phase(LAS unsigned char* lds, const Gemm g, const Sched& S, const Epi& E, const int tid) {
    const int wid = __builtin_amdgcn_readfirstlane(tid >> 6), lane = tid & 63, wr = wid >> 2, wc = wid & 3, fr = lane & 15, fq = lane >> 4;
    const int K = g.K, nt = K / BK;
    unsigned voffA[2], voffB[2];
#pragma unroll
    for (int i = 0; i < 2; ++i) { int R, C; stage_rc(tid * 16 + i * 8192, R, C); const int Rb = Epi::PERM ? ((R & ~31) + perm32(R & 31)) : R;
        voffA[i] = (unsigned)(R * K + C) * 2u; voffB[i] = (unsigned)(Rb * K + C) * 2u; }
    const size_t kstep = (size_t)(BK * 2);
    const size_t hstep = (size_t)HALF * K * 2;
    const size_t tstep = 2 * hstep;
    const unsigned ldsw = (unsigned)wid * 1024u;
    const int aoff = lds_byte(wr * 64 + fr, fq * 8), boff = lds_byte(wc * 32 + fr, fq * 8);
#define PG8_SA(b, h) (((b) * 2 + (h)) * HTB)
#define PG8_SB(b, h) ((4 + (b) * 2 + (h)) * HTB)
#define PG8_STAGE(bufoff, gbase, voff) do { _Pragma("unroll") for (int _i = 0; _i < 2; ++_i) \
        __builtin_amdgcn_global_load_lds((const unsigned*)((const char*)(gbase) + (voff)[_i]), (LAS unsigned*)(lds + (bufoff) + ldsw + _i * 8192), 16, 0, 0); } while (0)
#define PG8_LDA(dst, b, h) do { _Pragma("unroll") for (int m = 0; m < 4; ++m) _Pragma("unroll") for (int k = 0; k < 2; ++k) dst[m][k] = *(const LAS bf16x8*)(lds + PG8_SA(b, h) + aoff + m * 2048 + k * 1024); } while (0)
#define PG8_LDB(dst, b, h) do { _Pragma("unroll") for (int n = 0; n < 2; ++n) _Pragma("unroll") for (int k = 0; k < 2; ++k) dst[n][k] = *(const LAS bf16x8*)(lds + PG8_SB(b, h) + boff + n * 2048 + k * 1024); } while (0)
#define PG8_MMA(ai, bj, At, Bt) do { __builtin_amdgcn_s_setprio(1); _Pragma("unroll") for (int m = 0; m < 4; ++m) _Pragma("unroll") for (int n = 0; n < 2; ++n) _Pragma("unroll") for (int k = 0; k < 2; ++k) \
        acc[ai][bj][m][n] = __builtin_amdgcn_mfma_f32_16x16x32_bf16(Bt[n][k], At[m][k], acc[ai][bj][m][n], 0, 0, 0); __builtin_amdgcn_s_setprio(0); } while (0)
#define PG8_WAIT_V(n) asm volatile("s_waitcnt vmcnt(" #n ")" ::: "memory")
#define PG8_WAIT_L(n) asm volatile("s_waitcnt lgkmcnt(" #n ")" ::: "memory")
#define PG8_BAR __builtin_amdgcn_s_barrier()
#define PG8_SCHED __builtin_amdgcn_sched_barrier(0)
    Unit cur, nxt; int ui = 0;
    if (!S.next(0, cur)) return;
    f32x4 acc[2][2][4][2];
#pragma unroll
    for (int a = 0; a < 2; ++a)
#pragma unroll
        for (int b = 0; b < 2; ++b)
#pragma unroll
            for (int m = 0; m < 4; ++m)
#pragma unroll
                for (int n = 0; n < 2; ++n) acc[a][b][m][n] = (f32x4){0.f, 0.f, 0.f, 0.f};
    bf16x8 At[4][2], B0[2][2], B1[2][2];
    const char* cA = (const char*)g.A + (size_t)cur.pm * tstep; const char* cB = (const char*)g.Bt + (size_t)cur.pn * tstep;
    S.a_ready(cur);
    if constexpr (SP2) {
        PG8_STAGE(PG8_SB(0, 0), cB, voffB); PG8_STAGE(PG8_SB(0, 1), cB + hstep, voffB); PG8_STAGE(PG8_SA(0, 0), cA, voffA); PG8_STAGE(PG8_SA(0, 1), cA + hstep, voffA);
        if (wr == 1) PG8_BAR;
        PG8_WAIT_V(2); PG8_BAR;
        PG8_STAGE(PG8_SB(1, 0), cB + kstep, voffB); PG8_STAGE(PG8_SA(1, 0), cA + kstep, voffA); PG8_STAGE(PG8_SB(1, 1), cB + hstep + kstep, voffB);
        PG8_WAIT_V(6); PG8_BAR;
    } else {
        PG8_STAGE(PG8_SB(0, 0), cB, voffB); PG8_STAGE(PG8_SA(0, 0), cA, voffA); PG8_STAGE(PG8_SB(0, 1), cB + hstep, voffB); PG8_STAGE(PG8_SA(0, 1), cA + hstep, voffA);
        if (wr == 1) PG8_BAR;
        PG8_WAIT_V(4); PG8_BAR;
        PG8_STAGE(PG8_SB(1, 0), cB + kstep, voffB); PG8_STAGE(PG8_SA(1, 0), cA + kstep, voffA); PG8_STAGE(PG8_SB(1, 1), cB + hstep + kstep, voffB);
        PG8_WAIT_V(6); PG8_BAR;
    }
    for (;;) {
        const bool has_next = S.next(ui + 1, nxt);
        const char* nA = has_next ? (const char*)g.A + (size_t)nxt.pm * tstep : cA; const char* nB = has_next ? (const char*)g.Bt + (size_t)nxt.pn * tstep : cB;
        for (int t = 0; t < nt; t += 2) {
            const bool last = (t == nt - 2);
            const char* a1 = cA + (size_t)(t + 1) * kstep;
            const char* a2 = last ? nA : cA + (size_t)(t + 2) * kstep; const char* b2 = last ? nB : cB + (size_t)(t + 2) * kstep;
            const char* a3 = a2 + kstep; const char* b3 = b2 + kstep;
            if (last && has_next) S.a_ready(nxt);
            if constexpr (SP2) {
            PG8_LDB(B0, 0, 0); PG8_LDB(B1, 0, 1); PG8_SCHED; PG8_LDA(At, 0, 0); PG8_STAGE(PG8_SA(1, 1), a1 + hstep, voffA);
            PG8_WAIT_V(8); PG8_WAIT_L(0); PG8_BAR; PG8_MMA(0, 0, At, B0); PG8_MMA(0, 1, At, B1); PG8_BAR; PG8_SCHED;
            PG8_LDA(At, 0, 1); PG8_STAGE(PG8_SB(0, 0), b2, voffB); PG8_STAGE(PG8_SB(0, 1), b2 + hstep, voffB); PG8_STAGE(PG8_SA(0, 0), a2, voffA);
            PG8_WAIT_V(8); PG8_WAIT_L(0); PG8_BAR; PG8_MMA(1, 0, At, B0); PG8_MMA(1, 1, At, B1); PG8_BAR; PG8_SCHED;
            PG8_LDB(B0, 1, 0); PG8_LDB(B1, 1, 1); PG8_SCHED; PG8_LDA(At, 1, 0); PG8_STAGE(PG8_SA(0, 1), a2 + hstep, voffA);
            PG8_WAIT_V(8); PG8_WAIT_L(0); PG8_BAR; PG8_MMA(0, 0, At, B0); PG8_MMA(0, 1, At, B1); PG8_BAR; PG8_SCHED;
            PG8_LDA(At, 1, 1); PG8_STAGE(PG8_SB(1, 0), b3, voffB); PG8_STAGE(PG8_SB(1, 1), b3 + hstep, voffB); PG8_STAGE(PG8_SA(1, 0), a3, voffA);
            PG8_WAIT_V(8); PG8_WAIT_L(0); PG8_BAR; PG8_MMA(1, 0, At, B0); PG8_MMA(1, 1, At, B1); PG8_BAR; PG8_SCHED;
            } else {
            PG8_LDB(B0, 0, 0); PG8_SCHED; PG8_LDA(At, 0, 0); PG8_STAGE(PG8_SA(1, 1), a1 + hstep, voffA);
            PG8_WAIT_L(8); PG8_BAR; PG8_WAIT_L(0); PG8_MMA(0, 0, At, B0); PG8_BAR; PG8_SCHED;
            PG8_LDB(B1, 0, 1); PG8_STAGE(PG8_SB(0, 0), b2, voffB);
            PG8_BAR; PG8_WAIT_L(0); PG8_MMA(0, 1, At, B1); PG8_BAR;
            PG8_LDA(At, 0, 1); PG8_STAGE(PG8_SA(0, 0), a2, voffA);
            PG8_BAR; PG8_WAIT_L(0); PG8_MMA(1, 0, At, B0); PG8_BAR; PG8_SCHED;
            PG8_STAGE(PG8_SB(0, 1), b2 + hstep, voffB);
            PG8_WAIT_V(6); PG8_BAR; PG8_MMA(1, 1, At, B1); PG8_BAR;
            PG8_LDB(B0, 1, 0); PG8_SCHED; PG8_LDA(At, 1, 0); PG8_STAGE(PG8_SA(0, 1), a2 + hstep, voffA);
            PG8_WAIT_L(8); PG8_BAR; PG8_WAIT_L(0); PG8_MMA(0, 0, At, B0); PG8_BAR; PG8_SCHED;
            PG8_LDB(B1, 1, 1); PG8_STAGE(PG8_SB(1, 0), b3, voffB);
            PG8_BAR; PG8_WAIT_L(0); PG8_MMA(0, 1, At, B1); PG8_BAR;
            PG8_LDA(At, 1, 1); PG8_STAGE(PG8_SA(1, 0), a3, voffA);
            PG8_BAR; PG8_WAIT_L(0); PG8_MMA(1, 0, At, B0); PG8_BAR; PG8_SCHED;
            PG8_STAGE(PG8_SB(1, 1), b3 + hstep, voffB);
            PG8_WAIT_V(6); PG8_BAR; PG8_MMA(1, 1, At, B1); PG8_BAR;
            }
        }
        if constexpr (ALIGN_EPI) { if (wr == 0) PG8_BAR; }
        { int l2; asm volatile("v_mbcnt_lo_u32_b32 %0, -1, 0\n\tv_mbcnt_hi_u32_b32 %0, -1, %0" : "=v"(l2));
          E(acc, cur, wr, wc, l2 & 15, l2 >> 4);
          } S.done(cur);
        if (!has_next) break;
#pragma unroll
        for (int a = 0; a < 2; ++a)
#pragma unroll
            for (int b = 0; b < 2; ++b)
#pragma unroll
                for (int m = 0; m < 4; ++m)
#pragma unroll
                    for (int n = 0; n < 2; ++n) acc[a][b][m][n] = (f32x4){0.f, 0.f, 0.f, 0.f};
        cur = nxt; cA = nA; cB = nB; ++ui;
        if constexpr (ALIGN_EPI) { if (wr == 1) PG8_BAR; }
    }
    PG8_WAIT_V(0);
    if constexpr (!ALIGN_EPI) { if (wr == 0) PG8_BAR; }
    PG8_BAR;
#undef PG8_SA
#undef PG8_SB
#undef PG8_STAGE
#undef PG8_LDA
#undef PG8_LDB
#undef PG8_MMA
#undef PG8_WAIT_V
#undef PG8_WAIT_L
#undef PG8_BAR
#undef PG8_SCHED
}
}


template <class Sched>
__device__ __forceinline__ const LAS float* build_rstd_table(LAS unsigned char* lds, const Sched& S, const float* ssq, int tid, int& rsbase) {
    int pmin = 1 << 30, pmax = -1; pg8::Unit u;
    for (int i = 0; S.next(i, u); ++i) { pmin = u.pm < pmin ? u.pm : pmin; pmax = u.pm > pmax ? u.pm : pmax; }
    rsbase = pmin * 256;
    const int nrows = (pmax - pmin + 1) * 256;
    if (pmax < 0 || nrows > 4096) return nullptr;
    LAS float* tab = (LAS float*)(lds + LDS_RS);
    for (int r = tid; r < nrows; r += 512) tab[r] = row_rstd(ssq, rsbase + r);
    __syncthreads();
    return tab;
}

struct Args { const float* in[27]; float* out; unsigned char* ws; int ph_lo, ph_hi; };
typedef const __attribute__((address_space(4))) Args* ArgP;
enum { I_X = 0, I_RELB, I_F1N, I_F1G, I_F1U, I_F1D, I_MIXN, I_WIN, I_WGATE, I_BGATE, I_CONVW, I_CONVB, I_FW1, I_FB1, I_FW2, I_FB2, I_FW3, I_SKIP,
       I_QN, I_KN, I_WHY, I_WAT, I_WOUT, I_F2N, I_F2G, I_F2U, I_F2D };

__device__ __forceinline__ void tr_item(const float* W, int K, int N, bf16_t* WT, int dest_row0, const float* gain, LAS float* scr, int k0, int n0, int lane) {
    float v[32];
    const float* wp = W + (size_t)(k0 + (lane >> 5)) * N + n0 + (lane & 31);
#pragma unroll
    for (int i = 0; i < 32; ++i) v[i] = wp[(size_t)(2 * i) * N];
    if (gain) {
#pragma unroll
        for (int i = 0; i < 32; ++i) v[i] *= gain[k0 + 2 * i + (lane >> 5)];
    }
#pragma unroll
    for (int i = 0; i < 32; ++i) scr[(2 * i + (lane >> 5)) * 33 + (lane & 31)] = v[i];
    asm volatile("s_waitcnt lgkmcnt(0)" ::: "memory");
    const int c = lane & 7;
#pragma unroll
    for (int j = 0; j < 4; ++j) { const int n = (lane >> 3) + 8 * j; const LAS float* s = scr + (8 * c) * 33 + n;
        u32x4 o; o.x = pk2(s[0 * 33], s[1 * 33]); o.y = pk2(s[2 * 33], s[3 * 33]); o.z = pk2(s[4 * 33], s[5 * 33]); o.w = pk2(s[6 * 33], s[7 * 33]);
        *(u32x4*)(WT + (size_t)(dest_row0 + n) * K + k0 + 8 * c) = o; }
    asm volatile("s_waitcnt lgkmcnt(0)" ::: "memory");
}
__device__ __forceinline__ void tr_matrix(const float* W, int K, int N, bf16_t* WT, int row_off, int mode, const float* gain, LAS float* scr, int gw, int ngw, int lane) {
    const int nblk = N / 32, nitems = (K / 64) * nblk;
    for (int it = gw; it < nitems; it += ngw) {
        const int kb = it / nblk, nb = it % nblk, n0 = 32 * nb;
        int dr = row_off + n0;
        if (mode) dr = 256 * (n0 >> 7) + (mode == 2 ? 128 : 0) + (n0 & 127);
        tr_item(W, K, N, WT, dr, gain, scr, 64 * kb, n0, lane);
    }
}
__device__ __forceinline__ void convert_weights(ArgP a, int l, int mask, LAS unsigned char* lds, int gw, int ngw, int wave, int lane) {
    LAS float* scr = (LAS float*)(lds + wave * 16384);
    bf16_t* wb = (bf16_t*)(a->ws + WS_W);
    if (mask & 1) {
        const float* g1 = a->in[I_F1N] + (size_t)l * DM;
        tr_matrix(a->in[I_F1G] + (size_t)l * DM * DFF, DM, DFF, (bf16_t*)((char*)wb + W_UP1), 0, 1, g1, scr, gw, ngw, lane);
        tr_matrix(a->in[I_F1U] + (size_t)l * DM * DFF, DM, DFF, (bf16_t*)((char*)wb + W_UP1), 0, 2, g1, scr, gw, ngw, lane);
        tr_matrix(a->in[I_F1D] + (size_t)l * DFF * DM, DFF, DM, (bf16_t*)((char*)wb + W_DN1), 0, 0, nullptr, scr, gw, ngw, lane);
        const float* gm = a->in[I_MIXN] + (size_t)l * DM;
        tr_matrix(a->in[I_WIN] + (size_t)l * DM * INW, DM, INW, (bf16_t*)((char*)wb + W_IN), 0, 0, gm, scr, gw, ngw, lane);
        tr_matrix(a->in[I_WGATE] + (size_t)l * DM * GATEW, DM, GATEW, (bf16_t*)((char*)wb + W_IN), INW, 0, gm, scr, gw, ngw, lane);
    }
    if (mask & 2) {
        tr_matrix(a->in[I_WHY] + (size_t)l * 512 * DM, 512, DM, (bf16_t*)((char*)wb + W_HY), 0, 0, nullptr, scr, gw, ngw, lane);
        tr_matrix(a->in[I_WAT] + (size_t)l * 256 * DM, 256, DM, (bf16_t*)((char*)wb + W_AT), 0, 0, nullptr, scr, gw, ngw, lane);
        tr_matrix(a->in[I_WOUT] + (size_t)l * DM * DM, DM, DM, (bf16_t*)((char*)wb + W_OUT), 0, 0, nullptr, scr, gw, ngw, lane);
        const float* g2 = a->in[I_F2N] + (size_t)l * DM;
        tr_matrix(a->in[I_F2G] + (size_t)l * DM * DFF, DM, DFF, (bf16_t*)((char*)wb + W_UP2), 0, 1, g2, scr, gw, ngw, lane);
        tr_matrix(a->in[I_F2U] + (size_t)l * DM * DFF, DM, DFF, (bf16_t*)((char*)wb + W_UP2), 0, 2, g2, scr, gw, ngw, lane);
        tr_matrix(a->in[I_F2D] + (size_t)l * DFF * DM, DFF, DM, (bf16_t*)((char*)wb + W_DN2), 0, 0, nullptr, scr, gw, ngw, lane);
    }
}

__device__ __forceinline__ int t5_bucket(int rel) {
    const int ret = rel > 0 ? 16 : 0; const int n = rel < 0 ? -rel : rel;
    const float nf = (float)(n > 1 ? n : 1);
    int large = 8 + (int)(logf(nf / 8.0f) / 4.852030263919617f * 8.0f);
    large = large < 15 ? large : 15;
    return ret + (n < 8 ? n : large);
}
__device__ __forceinline__ void prologue(ArgP a, LAS unsigned char* lds, int gw, int ngw, int wave, int lane) {
    float* ssq = (float*)(a->ws + WS_SSQ);
    bf16_t* XB = (bf16_t*)(a->ws + WS_XB);
    const float* x = a->in[I_X];
    for (int m0 = gw * 4; m0 < TT; m0 += ngw * 4) {
        f32x4 v[4][4];
#pragma unroll
        for (int rr = 0; rr < 4; ++rr) { const f32x4* xr = (const f32x4*)(x + (size_t)(m0 + rr) * DM) + lane;
#pragma unroll
            for (int j = 0; j < 4; ++j) v[rr][j] = xr[64 * j]; }
#pragma unroll
        for (int rr = 0; rr < 4; ++rr) {
            float s = 0.f; u32x2* o8 = (u32x2*)(XB + (size_t)(m0 + rr) * DM) + lane;
#pragma unroll
            for (int j = 0; j < 4; ++j) { const f32x4 q = v[rr][j]; s += (q[0] * q[0] + q[1] * q[1]) + (q[2] * q[2] + q[3] * q[3]);
                u32x2 w; w.x = pk2(q[0], q[1]); w.y = pk2(q[2], q[3]); o8[64 * j] = w; }
            s = wave_sum(s); if (lane < 16) ssq[(size_t)(m0 + rr) * 16 + lane] = lane == 0 ? s : 0.f;
        }
    }
    { float* bt = (float*)(a->ws + WS_BTAB); const float* rb = a->in[I_RELB];
      for (int i = gw * 64 + lane; i < 12 * 129; i += ngw * 64) { const int hd = i / 129, ri = i % 129, g = hd >> 2; const int rel = (ri - 64) * (1 << (2 * g));
          bt[hd * 132 + ri] = rb[t5_bucket(rel) * 12 + hd]; } }
    { float* hid = (float*)(a->ws + WS_HID);
      for (int it = gw; it < NLAYER * SEQ; it += ngw) {
          const int l = it / SEQ, pos = it % SEQ;
          const float* w1 = a->in[I_FW1] + (size_t)l * 33 * 64; const float* b1 = a->in[I_FB1] + l * 64;
          const float* w2 = a->in[I_FW2] + (size_t)l * 64 * 64; const float* b2 = a->in[I_FB2] + l * 64;
          const float t = (float)pos / 4095.0f; const float w = (6.283185307179586f / 4096.0f) * (float)pos;
          float z = 0.f;
          if (lane == 0) z = t;
          else if (lane <= 16) { const float f = 1e-4f + (float)(lane - 1) * ((15.0f - 1e-4f) / 15.0f); z = cosf(f * w); }
          else if (lane <= 32) { const float f = 1e-4f + (float)(lane - 17) * ((15.0f - 1e-4f) / 15.0f); z = -sinf(f * w); }
          float h1 = b1[lane];
#pragma unroll
          for (int i = 0; i < 33; ++i) h1 += __int_as_float(__builtin_amdgcn_readlane(__float_as_int(z), i)) * w1[i * 64 + lane];
          h1 = sinf(h1);
          float h2 = b2[lane];
#pragma unroll
          for (int i = 0; i < 64; ++i) h2 += __int_as_float(__builtin_amdgcn_readlane(__float_as_int(h1), i)) * w2[i * 64 + lane];
          h2 = sinf(h2);
          hid[((size_t)l * 64 + lane) * SEQ + pos] = h2;
      } }
    convert_weights(a, 0, 3, lds, gw, ngw, wave, lane);
}

constexpr int UT_STRIDE = 8192 + 16, HY_UT = 0, HY_ZERO = 8 * UT_STRIDE, HY_F = HY_ZERO + 128, COPY_STRIDE = 16448, HY_RED = HY_F + 4 * COPY_STRIDE;
static_assert(HY_RED + 64 <= LDS_BYTES && HY_F % 8 == 0 && COPY_STRIDE % 8 == 0, "hyena LDS map");

__device__ __forceinline__ void conv8(const bf16_t* base, int n0, float w0, float w1, float w2, float bias, float (&out)[8]) {
    const u32x4 pw = *(const u32x4*)(base + n0);
    float p[10];
    { const float hv = bf1(base[n0 > 0 ? n0 - 1 : 0]); p[0] = n0 > 0 ? hv : 0.f; }
    p[1] = bf_lo(pw.x); p[2] = bf_hi(pw.x); p[3] = bf_lo(pw.y); p[4] = bf_hi(pw.y); p[5] = bf_lo(pw.z); p[6] = bf_hi(pw.z); p[7] = bf_lo(pw.w); p[8] = bf_hi(pw.w);
    { const float hv = bf1(base[(n0 + 8 < SEQ) ? n0 + 8 : n0]); p[9] = (n0 + 8 < SEQ) ? hv : 0.f; }
#pragma unroll
    for (int e = 0; e < 8; ++e) out[e] = w0 * p[e] + w1 * p[e + 1] + w2 * p[e + 2] + bias;
}


__device__ __forceinline__ void conv8_load(const bf16_t* base, int n0, u32x4& pw, unsigned short& hl, unsigned short& hr) {
    pw = *(const u32x4*)(base + n0);
    const unsigned short hl_ = base[n0 > 0 ? n0 - 1 : 0], hr_ = base[(n0 + 8 < SEQ) ? n0 + 8 : n0];
    hl = n0 > 0 ? hl_ : (unsigned short)0;
    hr = (n0 + 8 < SEQ) ? hr_ : (unsigned short)0;
}
__device__ __forceinline__ void conv8_calc(const u32x4 pw, unsigned short hl, unsigned short hr, float w0, float w1, float w2, float bias, float (&out)[8]) {
    float p[10];
    p[0] = bf1(hl);
    p[1] = bf_lo(pw.x); p[2] = bf_hi(pw.x); p[3] = bf_lo(pw.y); p[4] = bf_hi(pw.y); p[5] = bf_lo(pw.z); p[6] = bf_hi(pw.z); p[7] = bf_lo(pw.w); p[8] = bf_hi(pw.w);
    p[9] = bf1(hr);
#pragma unroll
    for (int e = 0; e < 8; ++e) out[e] = w0 * p[e] + w1 * p[e + 1] + w2 * p[e + 2] + bias;
}
#define FRESH_LANE(v) int v; asm volatile("v_mbcnt_lo_u32_b32 %0, -1, 0\n\tv_mbcnt_hi_u32_b32 %0, -1, %0" : "=v"(v))
__device__ __forceinline__ void filter_pass(LAS unsigned char* lds, ArgP a, int l, int bx, int G, int w) {
    FRESH_LANE(lane); const int tid = w * 64 + lane;
    const float* hid = (const float*)(a->ws + WS_HID) + (size_t)l * 64 * SEQ;
    const float* w3 = a->in[I_FW3] + (size_t)l * 64 * 2048;
    bf16_t* GB = (bf16_t*)(a->ws + WS_GBUF); float* FP = (float*)(a->ws + WS_FPART);
    LAS float* wT = (LAS float*)lds;
    LAS float* wsum = (LAS float*)(lds + 64 * 68 * 4);
    for (int item = bx; item < 256; item += G) {
        const int pb = item & 7, cg = item >> 3;
        __syncthreads();
#pragma unroll
        for (int i = 0; i < 8; ++i) { const int idx = tid + 512 * i, j = idx >> 6, cc = idx & 63; wT[cc * 68 + j] = w3[(size_t)j * 2048 + 64 * cg + cc]; }
        const int p = 512 * pb + tid;
        float h[64];
#pragma unroll
        for (int j = 0; j < 64; ++j) h[j] = hid[(size_t)j * SEQ + p];
        __syncthreads();
        const float t = (float)p / 4095.0f;
        const float mind = -3.0701134573253946f, maxd = -15.350567286626973f;
        for (int cc = 0; cc < 64; ++cc) {
            const LAS f32x4* wr4 = (const LAS f32x4*)(wT + cc * 68);
            float acc = 0.f;
#pragma unroll
            for (int j4 = 0; j4 < 16; ++j4) { const f32x4 wv = wr4[j4]; acc += h[4 * j4] * wv[0]; acc += h[4 * j4 + 1] * wv[1]; acc += h[4 * j4 + 2] * wv[2]; acc += h[4 * j4 + 3] * wv[3]; }
            const int col = 64 * cg + cc, c = col & 511, dir = (col >> 9) & 1, o = col >> 10;
            const float delta = fabsf(mind + (float)c * ((maxd - mind) / 511.0f));
            const float v = acc * __expf(-t * delta);
            const bool skip0 = (dir == 1) && (p == 0);
            float sq = skip0 ? 0.f : v * v;
            sq = wave_sum(sq);
            if (lane == 0) wsum[w * 64 + cc] = sq;
            if (!skip0) GB[(size_t)(o * 512 + c) * 8192 + (dir ? 4096 + p : 4096 - p)] = (bf16_t)(pk2(v, 0.f) & 0xffffu);
        }
        __syncthreads();
        if (tid < 64) { float sacc = 0.f;
#pragma unroll
            for (int ww = 0; ww < 8; ++ww) sacc += wsum[ww * 64 + tid];
            FP[(size_t)(64 * cg + tid) * 8 + pb] = sacc; }
    }
    __syncthreads();
}

template <int IG0, int IG1, bool CHECK = true>
__device__ __forceinline__ void hy_seg(LAS unsigned char* lds, f32x16 (&acc)[4], int d0, int d1, int abase, int bbase, int jbase) {
    bf16x8 A0, A1, B0[4], B1[4];
    int eight_ = 8; asm volatile("" : "+v"(eight_));
#define HY_LOAD(A, B, dd, ks) do { const int aa_ = abase - 128 * (dd) + 32 * (ks); const int ab_ = aa_ + eight_; \
        const u32x2 lo_ = *(const LAS u32x2*)(lds + aa_), hi_ = *(const LAS u32x2*)(lds + ab_); u32x4 av_; av_.x = lo_.x; av_.y = lo_.y; av_.z = hi_.x; av_.w = hi_.y; A = __builtin_bit_cast(bf16x8, av_); \
        _Pragma("unroll") for (int ig = IG0; ig < IG1; ++ig) { const int jb_ = jbase + 4 * ig - (dd); const int ba_ = (!CHECK || (unsigned)jb_ < 64u) ? (bbase + jb_ * 128 + 32 * (ks)) : HY_ZERO; B[ig] = *(const LAS bf16x8*)(lds + ba_); } } while (0)
#define HY_MMA(A, B) do { __builtin_amdgcn_s_setprio(1); _Pragma("unroll") for (int ig = IG0; ig < IG1; ++ig) acc[ig] = __builtin_amdgcn_mfma_f32_32x32x16_bf16(A, B[ig], acc[ig], 0, 0, 0); __builtin_amdgcn_s_setprio(0); } while (0)
#define HY_SB ((void)0)
    HY_LOAD(A0, B0, d0, 0);
#pragma unroll 1
    for (int d = d0; d <= d1; ++d) {
        HY_LOAD(A1, B1, d, 1); HY_SB; HY_MMA(A0, B0); HY_SB;
        HY_LOAD(A0, B0, d, 2); HY_SB; HY_MMA(A1, B1); HY_SB;
        HY_LOAD(A1, B1, d, 3); HY_SB; HY_MMA(A0, B0); HY_SB;
        HY_LOAD(A0, B0, d + 1, 0); HY_SB; HY_MMA(A1, B1); HY_SB;
    }
#undef HY_LOAD
#undef HY_MMA
#undef HY_SB
}

__device__ __forceinline__ void hyena_job(LAS unsigned char* lds, ArgP a, int l, int c, int w) {
    FRESH_LANE(lane); const int tid = w * 64 + lane, hh = lane >> 5, ql = lane & 31;
    bf16_t* PT = (bf16_t*)(a->ws + WS_PT);
    const float* cw = a->in[I_CONVW] + (size_t)l * 3 * 1536; const float* cb = a->in[I_CONVB] + (size_t)l * 1536;
    const float* skip = a->in[I_SKIP] + (size_t)l * 2 * 512;
    __syncthreads();
    if (tid < 32) ((LAS unsigned*)(lds + HY_ZERO))[tid] = 0u;
    {
        const float w0 = cw[c], w1 = cw[1536 + c], w2 = cw[3072 + c], bs = cb[c];
        const int n0 = 8 * tid;
#pragma unroll
        for (int b = 0; b < NB; ++b) {
            float o[8]; conv8(PT + (size_t)c * TT + b * SEQ, n0, w0, w1, w2, bs, o);
            u32x4 ww; ww.x = pk2(o[0], o[1]); ww.y = pk2(o[2], o[3]); ww.z = pk2(o[4], o[5]); ww.w = pk2(o[6], o[7]);
            *(LAS u32x4*)(lds + HY_UT + b * UT_STRIDE + n0 * 2) = ww;
        }
    }
    const int rhalf = w & 1, Wq = w >> 1;
    for (int o = 0; o < 2; ++o) {
        float nrm;
        {
            FRESH_LANE(lane_f); const int tid = w * 64 + lane_f;
            int zoff = 0; asm volatile("" : "+v"(zoff));
            const bf16_t* gb = (const bf16_t*)(a->ws + WS_GBUF) + (size_t)(o * 512 + c) * 8192 + zoff;
            const float* fp = (const float*)(a->ws + WS_FPART) + zoff;
            unsigned short gv[16];
#pragma unroll
            for (int k = 0; k < 16; ++k) gv[k] = gb[tid + 512 * k];
            float tot = 0.f;
#pragma unroll
            for (int pb = 0; pb < 8; ++pb) tot += fp[(size_t)(o * 1024 + c) * 8 + pb];
#pragma unroll
            for (int pb = 0; pb < 8; ++pb) tot += fp[(size_t)(o * 1024 + 512 + c) * 8 + pb];
            nrm = rsqrtf(tot + EPS); asm volatile("" : "+v"(nrm));
#pragma unroll
            for (int k = 0; k < 16; ++k) { const int t = tid + 512 * k;
#pragma unroll
                for (int sft = 0; sft < 4; ++sft) if (t - sft >= 0) *(LAS bf16_t*)(lds + HY_F + sft * COPY_STRIDE + (t - sft) * 2) = gv[k]; }
        }
        __syncthreads();
        f32x16 acc[4];
#pragma unroll
        for (int ig = 0; ig < 4; ++ig)
#pragma unroll
            for (int e = 0; e < 16; ++e) acc[ig][e] = 0.f;
        {
            FRESH_LANE(lane_m); const int hh = lane_m >> 5, ql = lane_m & 31;
            const int r = 32 * rhalf + ql;
            const int sh = (4 - (r & 3)) & 3;
            const int abase = HY_F + sh * COPY_STRIDE + (4096 - r + 8 * hh - sh) * 2;
            const int il = ql >> 3, bb = ql & 7;
            const int bbase = HY_UT + bb * UT_STRIDE + (8 * hh) * 2;
            const int jbase = 16 * Wq + il, dlo = 16 * Wq - 63;
            hy_seg<0, 1>(lds, acc, dlo, dlo + 3, abase, bbase, jbase);
            hy_seg<0, 2>(lds, acc, dlo + 4, dlo + 7, abase, bbase, jbase);
            hy_seg<0, 3>(lds, acc, dlo + 8, dlo + 11, abase, bbase, jbase);
            hy_seg<0, 4>(lds, acc, dlo + 12, 16 * Wq - 49, abase, bbase, jbase);
            hy_seg<0, 4, false>(lds, acc, 16 * Wq - 48, 16 * Wq - 1, abase, bbase, jbase);
            hy_seg<0, 4>(lds, acc, 16 * Wq, 16 * Wq + 3, abase, bbase, jbase);
            hy_seg<1, 4>(lds, acc, 16 * Wq + 4, 16 * Wq + 7, abase, bbase, jbase);
            hy_seg<2, 4>(lds, acc, 16 * Wq + 8, 16 * Wq + 11, abase, bbase, jbase);
            hy_seg<3, 4>(lds, acc, 16 * Wq + 12, 16 * Wq + 15, abase, bbase, jbase);
        }
        __syncthreads();
        {
            FRESH_LANE(lane_y); const int hh = lane_y >> 5, ql = lane_y & 31, il = ql >> 3, bb = ql & 7;
            const float sk = skip[o * 512 + c];
#pragma unroll
            for (int ig = 0; ig < 4; ++ig) {
                const int i = 16 * Wq + 4 * ig + il;
#pragma unroll
                for (int q4 = 0; q4 < 4; ++q4) {
                    const int n = 64 * i + 32 * rhalf + 8 * q4 + 4 * hh;
                    LAS u32x2* up = (LAS u32x2*)(lds + HY_UT + bb * UT_STRIDE + n * 2);
                    const u32x2 uw = *up;
                    u32x2 yw; yw.x = pk2(nrm * acc[ig][4 * q4 + 0] + sk * bf_lo(uw.x), nrm * acc[ig][4 * q4 + 1] + sk * bf_hi(uw.x));
                    yw.y = pk2(nrm * acc[ig][4 * q4 + 2] + sk * bf_lo(uw.y), nrm * acc[ig][4 * q4 + 3] + sk * bf_hi(uw.y));
                    *up = yw;
                }
            }
        }
        __syncthreads();
        {
            FRESH_LANE(lane_g); const int tid = w * 64 + lane_g;
            const int gc = 512 * (o + 1) + c;
            const float w0 = cw[gc], w1 = cw[1536 + gc], w2 = cw[3072 + gc], bs = cb[gc];
            const int n0 = 8 * tid;
            u32x4 gpw[NB]; unsigned short ghl[NB], ghr[NB];
#pragma unroll
            for (int b = 0; b < NB; ++b) conv8_load(PT + (size_t)gc * TT + b * SEQ, n0, gpw[b], ghl[b], ghr[b]);
            asm volatile("" ::: "memory");
#pragma unroll
            for (int b = 0; b < NB; ++b) {
                float x[8]; conv8_calc(gpw[b], ghl[b], ghr[b], w0, w1, w2, bs, x);
                LAS u32x4* yp = (LAS u32x4*)(lds + HY_UT + b * UT_STRIDE + n0 * 2);
                const u32x4 yw = *yp;
                u32x4 zw; zw.x = pk2(x[0] * bf_lo(yw.x), x[1] * bf_hi(yw.x)); zw.y = pk2(x[2] * bf_lo(yw.y), x[3] * bf_hi(yw.y));
                zw.z = pk2(x[4] * bf_lo(yw.z), x[5] * bf_hi(yw.z)); zw.w = pk2(x[6] * bf_lo(yw.w), x[7] * bf_hi(yw.w));
                if (o == 0) *yp = zw; else *(u32x4*)(PT + (size_t)c * TT + b * SEQ + n0) = zw;
            }
        }
        __syncthreads();
    }
}

constexpr int AT_K = 0, AT_KROW = 144, AT_VT = 384 * AT_KROW, AT_VROW = 392 * 2, AT_BT = AT_VT + 64 * AT_VROW;
static_assert(AT_BT + 132 * 4 <= LDS_BYTES, "attention LDS map");

__device__ __forceinline__ void attn_unit(LAS unsigned char* lds, ArgP a, int l, int u, int w) {
    FRESH_LANE(lane); const int tid = w * 64 + lane, hh = lane >> 5, ql = lane & 31;
    const bf16_t* QKV = (const bf16_t*)(a->ws + WS_QKV);
    bf16_t* OG = (bf16_t*)(a->ws + WS_OG); float* LSE = (float*)(a->ws + WS_LSE);
    const float* btab = (const float*)(a->ws + WS_BTAB);
    const float* qn = a->in[I_QN] + l * 64; const float* kn = a->in[I_KN] + l * 64;
    const int g = u >> 9, v = u & 511, b = v >> 6, rem = v & 63;
    const int dsh = 2 * g, m = SEQ >> dsh, nQb = m >> 8;
    const int Qb = rem % nQb, h = (rem / nQb) & 3, rho = rem / (4 * nQb);
    const int kidx0 = 256 * Qb - 64;
    const int q0 = 32 * w;
    const int qidx = 256 * Qb + q0 + ql;
    const size_t qrow = (size_t)b * SEQ + rho + ((size_t)qidx << dsh);
    u32x4 qw[4];
    { const bf16_t* qp = QKV + qrow * QKVW + g * 256 + h * 64 + 8 * hh;
#pragma unroll
      for (int ks = 0; ks < 4; ++ks) qw[ks] = *(const u32x4*)(qp + 16 * ks); }
    f32x4 gq[4][2];
#pragma unroll
    for (int ks = 0; ks < 4; ++ks)
#pragma unroll
        for (int hf = 0; hf < 2; ++hf) gq[ks][hf] = *(const f32x4*)(qn + 16 * ks + 8 * hh + 4 * hf) * *(const f32x4*)(kn + 16 * ks + 8 * hh + 4 * hf);
    u32x4 kw[8], vw[8]; float btv = 0.f;
    const int kl = tid; const int kidx_t = kidx0 + kl; const bool ok = kidx_t >= 0 && kidx_t < m;
    if (tid < 384) {
        const size_t row = (size_t)b * SEQ + rho + ((size_t)(ok ? kidx_t : 0) << dsh);
        const bf16_t* rp = QKV + row * QKVW + g * 256 + h * 64;
#pragma unroll
        for (int c8 = 0; c8 < 8; ++c8) { kw[c8] = *(const u32x4*)(rp + 768 + 8 * c8); vw[c8] = *(const u32x4*)(rp + 1536 + 8 * c8); }
    } else if (tid < 384 + 129) btv = btab[(g * 4 + h) * 132 + (tid - 384)];
    __syncthreads();
    {
        if (tid < 384) {
            if (!ok) {
#pragma unroll
                for (int c8 = 0; c8 < 8; ++c8) { kw[c8] = (u32x4){0u, 0u, 0u, 0u}; vw[c8] = (u32x4){0u, 0u, 0u, 0u}; }
            }
            float s = 0.f;
#pragma unroll
            for (int c8 = 0; c8 < 8; ++c8) {
                const float f[8] = {bf_lo(kw[c8].x), bf_hi(kw[c8].x), bf_lo(kw[c8].y), bf_hi(kw[c8].y), bf_lo(kw[c8].z), bf_hi(kw[c8].z), bf_lo(kw[c8].w), bf_hi(kw[c8].w)};
#pragma unroll
                for (int e = 0; e < 8; ++e) s += f[e] * f[e];
            }
            const float rs = rsqrtf(s * (1.0f / 64.0f) + EPS);
#pragma unroll
            for (int c8 = 0; c8 < 8; ++c8) {
                const float f[8] = {bf_lo(kw[c8].x), bf_hi(kw[c8].x), bf_lo(kw[c8].y), bf_hi(kw[c8].y), bf_lo(kw[c8].z), bf_hi(kw[c8].z), bf_lo(kw[c8].w), bf_hi(kw[c8].w)};
                u32x4 ko; ko.x = pk2(f[0] * rs, f[1] * rs); ko.y = pk2(f[2] * rs, f[3] * rs);
                ko.z = pk2(f[4] * rs, f[5] * rs); ko.w = pk2(f[6] * rs, f[7] * rs);
                *(LAS u32x4*)(lds + AT_K + kl * AT_KROW + 16 * c8) = ko;
                LAS bf16_t* vt = (LAS bf16_t*)(lds + AT_VT + (8 * c8) * AT_VROW + kl * 2);
                vt[0 * (AT_VROW / 2)] = (bf16_t)(vw[c8].x & 0xffffu); vt[1 * (AT_VROW / 2)] = (bf16_t)(vw[c8].x >> 16);
                vt[2 * (AT_VROW / 2)] = (bf16_t)(vw[c8].y & 0xffffu); vt[3 * (AT_VROW / 2)] = (bf16_t)(vw[c8].y >> 16);
                vt[4 * (AT_VROW / 2)] = (bf16_t)(vw[c8].z & 0xffffu); vt[5 * (AT_VROW / 2)] = (bf16_t)(vw[c8].z >> 16);
                vt[6 * (AT_VROW / 2)] = (bf16_t)(vw[c8].w & 0xffffu); vt[7 * (AT_VROW / 2)] = (bf16_t)(vw[c8].w >> 16);
            }
        } else if (tid < 384 + 129) {
            ((LAS float*)(lds + AT_BT))[tid - 384] = btv;
        }
    }
    __syncthreads();
    bf16x8 qf[4];
    {
        float s = 0.f;
#pragma unroll
        for (int ks = 0; ks < 4; ++ks) {
            const float f[8] = {bf_lo(qw[ks].x), bf_hi(qw[ks].x), bf_lo(qw[ks].y), bf_hi(qw[ks].y), bf_lo(qw[ks].z), bf_hi(qw[ks].z), bf_lo(qw[ks].w), bf_hi(qw[ks].w)};
#pragma unroll
            for (int e = 0; e < 8; ++e) s += f[e] * f[e]; }
        s += shx(s, 32);
        const float rs = rsqrtf(s * (1.0f / 64.0f) + EPS);
#pragma unroll
        for (int ks = 0; ks < 4; ++ks) {
            const float gp[8] = {gq[ks][0][0], gq[ks][0][1], gq[ks][0][2], gq[ks][0][3], gq[ks][1][0], gq[ks][1][1], gq[ks][1][2], gq[ks][1][3]};
            const float f[8] = {bf_lo(qw[ks].x), bf_hi(qw[ks].x), bf_lo(qw[ks].y), bf_hi(qw[ks].y), bf_lo(qw[ks].z), bf_hi(qw[ks].z), bf_lo(qw[ks].w), bf_hi(qw[ks].w)};
            u32x4 o; o.x = pk2(f[0] * rs * gp[0], f[1] * rs * gp[1]); o.y = pk2(f[2] * rs * gp[2], f[3] * rs * gp[3]);
            o.z = pk2(f[4] * rs * gp[4], f[5] * rs * gp[5]); o.w = pk2(f[6] * rs * gp[6], f[7] * rs * gp[7]);
            qf[ks] = __builtin_bit_cast(bf16x8, o);
        }
    }
    f32x16 st[5];
#pragma unroll
    for (int kt = 0; kt < 5; ++kt) {
#pragma unroll
        for (int e = 0; e < 16; ++e) st[kt][e] = 0.f;
#pragma unroll
        for (int ks = 0; ks < 4; ++ks) {
            const bf16x8 kfr = *(const LAS bf16x8*)(lds + AT_K + (q0 + 32 * kt + ql) * AT_KROW + (16 * ks + 8 * hh) * 2);
            st[kt] = __builtin_amdgcn_mfma_f32_32x32x16_bf16(kfr, qf[ks], st[kt], 0, 0, 0);
        }
    }
    const LAS float* bt = (const LAS float*)(lds + AT_BT);
    float mx = -1e30f;
#pragma unroll
    for (int kt = 0; kt < 5; ++kt) {
        float bv[16];
#pragma unroll
        for (int e = 0; e < 16; ++e) {
            const int cr = (e & 3) + 8 * (e >> 2) + 4 * hh;
            int ri = 32 * kt + cr - ql; ri = ri < 0 ? 0 : (ri > 128 ? 128 : ri);
            bv[e] = bt[ri];
        }
#pragma unroll
        for (int e = 0; e < 16; ++e) {
            const int cr = (e & 3) + 8 * (e >> 2) + 4 * hh;
            const int rel = 32 * kt + cr - 64 - ql;
            const int kidx = kidx0 + q0 + 32 * kt + cr;
            const bool ok = rel >= -64 && rel <= 64 && kidx >= 0 && kidx < m;
            const float sv = st[kt][e] * 0.125f + bv[e];
            const float s = ok ? sv : -1e30f;
            st[kt][e] = s; mx = fmaxf(mx, s);
        }
    }
    mx = fmaxf(mx, shx(mx, 32));
    float den = 0.f;
#pragma unroll
    for (int kt = 0; kt < 5; ++kt)
#pragma unroll
        for (int e = 0; e < 16; ++e) { const float p = st[kt][e] > -1e29f ? __expf(st[kt][e] - mx) : 0.f; st[kt][e] = p; den += p; }
    den += shx(den, 32);
    f32x16 ot[2];
#pragma unroll
    for (int dt = 0; dt < 2; ++dt)
#pragma unroll
        for (int e = 0; e < 16; ++e) ot[dt][e] = 0.f;
#pragma unroll
    for (int kt = 0; kt < 5; ++kt)
#pragma unroll
        for (int s2 = 0; s2 < 2; ++s2) {
            u32x4 pw; pw.x = pk2(st[kt][8 * s2 + 0], st[kt][8 * s2 + 1]); pw.y = pk2(st[kt][8 * s2 + 2], st[kt][8 * s2 + 3]);
            pw.z = pk2(st[kt][8 * s2 + 4], st[kt][8 * s2 + 5]); pw.w = pk2(st[kt][8 * s2 + 6], st[kt][8 * s2 + 7]);
            const bf16x8 pb = __builtin_bit_cast(bf16x8, pw);
#pragma unroll
            for (int dt = 0; dt < 2; ++dt) {
                const int va = AT_VT + (32 * dt + ql) * AT_VROW + (q0 + 32 * kt + 16 * s2 + 4 * hh) * 2;
                const u32x2 lo = *(const LAS u32x2*)(lds + va), hi = *(const LAS u32x2*)(lds + va + 16);
                u32x4 av; av.x = lo.x; av.y = lo.y; av.z = hi.x; av.w = hi.y;
                ot[dt] = __builtin_amdgcn_mfma_f32_32x32x16_bf16(__builtin_bit_cast(bf16x8, av), pb, ot[dt], 0, 0, 0);
            }
        }
    const float inv = 1.0f / den;
    bf16_t* op = OG + ((size_t)g * TT + qrow) * 256 + h * 64;
#pragma unroll
    for (int dt = 0; dt < 2; ++dt)
#pragma unroll
        for (int q4 = 0; q4 < 4; ++q4) {
            u32x2 ow; ow.x = pk2(ot[dt][4 * q4 + 0] * inv, ot[dt][4 * q4 + 1] * inv); ow.y = pk2(ot[dt][4 * q4 + 2] * inv, ot[dt][4 * q4 + 3] * inv);
            *(u32x2*)(op + 32 * dt + 8 * q4 + 4 * hh) = ow;
        }
    if (hh == 0) LSE[((size_t)g * TT + qrow) * 4 + h] = mx + __logf(den);
}

__device__ __forceinline__ void trans_combine(LAS unsigned char* lds, ArgP a, int tid, int bx, int G) {
    const bf16_t* PT = (const bf16_t*)(a->ws + WS_PT); bf16_t* YHY = (bf16_t*)(a->ws + WS_YHY);
    const bf16_t* __restrict__ OG = (const bf16_t*)(a->ws + WS_OG); const float* __restrict__ LSE = (const float*)(a->ws + WS_LSE); bf16_t* __restrict__ YAT = (bf16_t*)(a->ws + WS_YAT);
    constexpr int TROW = 72 * 2;
    {
        const int lane = tid & 63, wv = tid >> 6;
        LAS unsigned char* tl = lds + wv * (64 * TROW);
        for (int tile = bx * 8 + wv; tile < 8 * 512; tile += G * 8) {
            const int cb = tile & 7, tb = tile >> 3, c8 = lane & 7;
            u32x4 v[8];
#pragma unroll
            for (int it = 0; it < 8; ++it) { const int ch = (lane >> 3) + 8 * it; v[it] = *(const u32x4*)(PT + (size_t)(64 * cb + ch) * TT + 64 * tb + 8 * c8); }
#pragma unroll
            for (int it = 0; it < 8; ++it) { const int ch = (lane >> 3) + 8 * it; *(LAS u32x4*)(tl + ch * TROW + 16 * c8) = v[it]; }
#pragma unroll
            for (int it = 0; it < 8; ++it) { const int tok = (lane >> 3) + 8 * it;
                const LAS bf16_t* sp = (const LAS bf16_t*)(tl + (8 * c8) * TROW + tok * 2);
                unsigned e[8];
#pragma unroll
                for (int k = 0; k < 8; ++k) e[k] = sp[k * (TROW / 2)];
                u32x4 o; o.x = e[0] | (e[1] << 16); o.y = e[2] | (e[3] << 16); o.z = e[4] | (e[5] << 16); o.w = e[6] | (e[7] << 16);
                *(u32x4*)(YHY + (size_t)(64 * tb + tok) * 512 + 64 * cb + 8 * c8) = o; }
        }
    }
#pragma unroll 4
    for (size_t i = (size_t)bx * 512 + tid; i < (size_t)TT * 32; i += (size_t)G * 512) {
        const size_t row = i >> 5; const int c8 = (int)(i & 31), h = c8 >> 3;
        const float l0 = LSE[(0 * (size_t)TT + row) * 4 + h], l1 = LSE[(1 * (size_t)TT + row) * 4 + h], l2 = LSE[(2 * (size_t)TT + row) * 4 + h];
        const float mxl = fmaxf(l0, fmaxf(l1, l2));
        float e0 = __expf(l0 - mxl), e1 = __expf(l1 - mxl), e2 = __expf(l2 - mxl);
        const float inv = 1.0f / (e0 + e1 + e2); e0 *= inv; e1 *= inv; e2 *= inv;
        const u32x4 a0 = *(const u32x4*)(OG + (0 * (size_t)TT + row) * 256 + 8 * c8), a1 = *(const u32x4*)(OG + (1 * (size_t)TT + row) * 256 + 8 * c8),
                    a2 = *(const u32x4*)(OG + (2 * (size_t)TT + row) * 256 + 8 * c8);
        u32x4 o;
        o.x = pk2(e0 * bf_lo(a0.x) + e1 * bf_lo(a1.x) + e2 * bf_lo(a2.x), e0 * bf_hi(a0.x) + e1 * bf_hi(a1.x) + e2 * bf_hi(a2.x));
        o.y = pk2(e0 * bf_lo(a0.y) + e1 * bf_lo(a1.y) + e2 * bf_lo(a2.y), e0 * bf_hi(a0.y) + e1 * bf_hi(a1.y) + e2 * bf_hi(a2.y));
        o.z = pk2(e0 * bf_lo(a0.z) + e1 * bf_lo(a1.z) + e2 * bf_lo(a2.z), e0 * bf_hi(a0.z) + e1 * bf_hi(a1.z) + e2 * bf_hi(a2.z));
        o.w = pk2(e0 * bf_lo(a0.w) + e1 * bf_lo(a1.w) + e2 * bf_lo(a2.w), e0 * bf_hi(a0.w) + e1 * bf_hi(a1.w) + e2 * bf_hi(a2.w));
        *(u32x4*)(YAT + row * 256 + 8 * c8) = o;
    }
}


#define XB_TMO      128
#define XB_XCNT(j)  (256  + 64 * (j))
#define XB_XSUB(j)  (1280 + 64 * (j))
#define XB_XGEN(j)  (2304 + 64 * (j))
#define XB_TOP      3328
#define XB_TOPGEN   3392
#define XCD_BAR_WORDS 3456
#define XB_SPIN_CAP (1u << 22)
__device__ __forceinline__ unsigned xb_ld(unsigned* p)              { return __hip_atomic_load(p, __ATOMIC_RELAXED, __HIP_MEMORY_SCOPE_AGENT); }
__device__ __forceinline__ unsigned xb_add(unsigned* p, unsigned v) { return __hip_atomic_fetch_add(p, v, __ATOMIC_RELAXED, __HIP_MEMORY_SCOPE_AGENT); }
__device__ __forceinline__ unsigned xb_xcc_id() { return (unsigned)__builtin_amdgcn_s_getreg((3 << 11) | 20) & 0xFu; }
#define XB_SPIN(cond, bar) do { unsigned _sp = 0; while (cond) { __builtin_amdgcn_s_sleep(1); \
    if ((++_sp & 255u) == 0u) { if (xb_ld(&(bar)[XB_TMO])) break; if (_sp > XB_SPIN_CAP) { atomicAdd(&(bar)[XB_TMO], 1u); break; } } } } while (0)
__device__ __forceinline__ void xcd_barrier_complete(unsigned* bar, unsigned x, unsigned& nloc, unsigned& nx) {
    const unsigned G = gridDim.x * gridDim.y * gridDim.z;
    unsigned sum, cnt, mine, sp = 0u;
    for (;;) {
        sum = 0u; cnt = 0u; mine = 0u;
#pragma unroll
        for (unsigned j = 0; j < 16; ++j) { const unsigned c = xb_ld(&bar[XB_XCNT(j)]); sum += c; cnt += (c > 0u) ? 1u : 0u; mine = (j == x) ? c : mine; }
        if (sum == G) break;
        __builtin_amdgcn_s_sleep(1);
        if ((++sp & 255u) == 0u) { if (xb_ld(&bar[XB_TMO])) break; if (sp > XB_SPIN_CAP) { atomicAdd(&bar[XB_TMO], 1u); break; } }
    }
    nloc = mine > 0u ? mine : 1u; nx = cnt > 0u ? cnt : 1u;
}
__device__ __forceinline__ void xcd_barrier(unsigned* bar, volatile LAS unsigned* st) {
    asm volatile("s_waitcnt vmcnt(0)" ::: "memory");
    __syncthreads();
    if (threadIdx.x == 0) {
        __builtin_amdgcn_s_waitcnt(0);
        const unsigned x = xb_xcc_id();
        unsigned nloc = st[0], nx = st[1];
        if (nloc == 0u) { xcd_barrier_complete(bar, x, nloc, nx); st[0] = nloc; st[1] = nx; }
        const unsigned old = xb_add(&bar[XB_XSUB(x)], 1u);
        const unsigned gen = old / nloc;
        if (old + 1u == (gen + 1u) * nloc) {
            __builtin_amdgcn_fence(__ATOMIC_RELEASE, "agent");
            asm volatile("s_waitcnt vmcnt(0)" ::: "memory");
            const unsigned og = xb_add(&bar[XB_TOP], 1u);
            const unsigned tg = og / nx;
            if (og + 1u == (tg + 1u) * nx) xb_add(&bar[XB_TOPGEN], 1u);
            else XB_SPIN(xb_ld(&bar[XB_TOPGEN]) == tg, bar);
            __builtin_amdgcn_fence(__ATOMIC_ACQUIRE, "agent");
            xb_add(&bar[XB_XGEN(x)], 1u);
            asm volatile("s_waitcnt vmcnt(0)" ::: "memory");
        } else {
            XB_SPIN(xb_ld(&bar[XB_XGEN(x)]) == gen, bar);
            __builtin_amdgcn_fence(__ATOMIC_ACQUIRE, "agent");
            asm volatile("s_waitcnt vmcnt(0)" ::: "memory");
        }
    }
    __syncthreads();
}

constexpr int N_PHASES = 1 + 9 * NLAYER;
#define PHASE_IDS \
    int lane; asm volatile("v_mbcnt_lo_u32_b32 %0, -1, 0\n\tv_mbcnt_hi_u32_b32 %0, -1, %0" : "=v"(lane)); \
    int G = gridDim.x, bx = blockIdx.x, wave = wave0; asm volatile("" : "+s"(G), "+s"(bx), "+s"(wave)); \
    const int tid = wave * 64 + lane; const int gw = bx * 8 + wave, ngw = G * 8; (void)gw; (void)ngw; (void)tid;
__global__ void __launch_bounds__(512, 2) hybrid_fwd(Args args_unused) {
    extern __shared__ __attribute__((aligned(16))) unsigned char lds_raw[];
    LAS unsigned char* lds = (LAS unsigned char*)lds_raw;
    cg::grid_group grid = cg::this_grid();
    const int wave0 = __builtin_amdgcn_readfirstlane(threadIdx.x >> 6);
    ArgP ap0 = (ArgP)__builtin_amdgcn_kernarg_segment_ptr();
    const int ph_lo = ap0->ph_lo, ph_hi = ap0->ph_hi;
    if (threadIdx.x < 16) ((LAS unsigned*)(lds + LDS_MISC))[threadIdx.x] = 0u;
    if (threadIdx.x == 0 && ph_hi - ph_lo > 1) (void)xb_add((unsigned*)(ap0->ws + WS_BAR) + XB_XCNT(xb_xcc_id()), 1u);
    __syncthreads();
#define WPTR(off) ((const bf16_t*)((const char*)Wb + (off)))
    for (int ph = ph_lo; ph < ph_hi; ++ph) {
        ArgP args = ap0; asm volatile("" : "+s"(args));
        unsigned char* ws = args->ws;
        float* ssq = (float*)(ws + WS_SSQ);
        bf16_t* XB = (bf16_t*)(ws + WS_XB);
        bf16_t* Hb = (bf16_t*)(ws + WS_H);
        const bf16_t* Wb = (const bf16_t*)(ws + WS_W);
        if (ph == 0) {
            PHASE_IDS
            prologue(args, lds, gw, ngw, wave, lane);
        } else {
            const int l = (ph - 1) / 9, k = (ph - 1) % 9;
            if (k == 0 || k == 7) {
                PHASE_IDS
                const int which = (k == 7);
                pg8::Gemm g{XB, WPTR(which ? W_UP2 : W_UP1), TT, 2 * DFF, DM};
                pg8::StaticOrder S; S.init(TT, 2 * DFF, G, bx);
                int rsbase = 0; const LAS float* rstab = build_rstd_table(lds, S, ssq, tid, rsbase);
                pg8::EpiFfnUp E{Hb, ssq, rstab, rsbase};
                pg8::gemm_phase<pg8::EpiFfnUp, pg8::StaticOrder>(lds, g, S, E, tid);
            } else if (k == 1 || k == 8 || k == 6) {
                PHASE_IDS
                if (k == 1) filter_pass(lds, args, l, bx, G, wave);
                const bool isout = (k == 6);
                pg8::Gemm g{isout ? (const bf16_t*)(ws + WS_Y) : Hb, WPTR(k == 1 ? W_DN1 : (k == 8 ? W_DN2 : W_OUT)), TT, DM, isout ? DM : DFF};
                pg8::StaticOrder S; S.init(TT, DM, G, bx);
                const float* xin = (l == 0 && k == 1) ? args->in[I_X] : args->out;
                const bool lastp = (l == NLAYER - 1 && k == 8);
                pg8::EpiResid E{xin, args->out, XB, lastp ? nullptr : ssq, isout ? 1.0f : 0.5f};
                pg8::gemm_phase<pg8::EpiResid, pg8::StaticOrder>(lds, g, S, E, tid);
            } else if (k == 2) {
                PHASE_IDS
                pg8::Gemm g{XB, WPTR(W_IN), TT, INW + GATEW, DM};
                pg8::StaticOrder S; S.init(TT, INW + GATEW, G, bx);
                int rsbase = 0; const LAS float* rstab = build_rstd_table(lds, S, ssq, tid, rsbase);
                pg8::EpiWin E{(bf16_t*)(ws + WS_PT), (bf16_t*)(ws + WS_QKV), (bf16_t*)(ws + WS_G), ssq, args->in[I_BGATE] + (size_t)l * GATEW, rstab, rsbase};
                pg8::gemm_phase<pg8::EpiWin, pg8::StaticOrder>(lds, g, S, E, tid);
            } else if (k == 3) {
                PHASE_IDS
                #ifndef NO_HY
                for (int c = bx; c < HYW; c += G) hyena_job(lds, args, l, c, wave);
#endif
                #ifndef NO_AT
                for (int u = bx; u < 1536; u += G) attn_unit(lds, args, l, u, wave);
#endif
            } else if (k == 4) {
                PHASE_IDS
                trans_combine(lds, args, tid, bx, G);
                __syncthreads();
                if (l == 0) convert_weights(args, 1, 1, lds, gw, ngw, wave, lane);
                else convert_weights(args, 1, 2, lds, gw, ngw, wave, lane);
            } else if (k == 5) {
                PHASE_IDS
                pg8::StaticOrder S; S.init(TT, DM, G, bx);
                { pg8::Gemm g{(const bf16_t*)(ws + WS_YHY), WPTR(W_HY), TT, DM, 512};
                  pg8::EpiMerge<false> E{(bf16_t*)(ws + WS_Y), (const bf16_t*)(ws + WS_G), 0};
                  pg8::gemm_phase<pg8::EpiMerge<false>, pg8::StaticOrder>(lds, g, S, E, tid); }
                { pg8::Gemm g{(const bf16_t*)(ws + WS_YAT), WPTR(W_AT), TT, DM, 256};
                  pg8::EpiMerge<true> E{(bf16_t*)(ws + WS_Y), (const bf16_t*)(ws + WS_G), DM};
                  pg8::gemm_phase<pg8::EpiMerge<true>, pg8::StaticOrder>(lds, g, S, E, tid); }
            }
        }
        if (ph + 1 < ph_hi) {
            if (ph_hi > 1000000) grid.sync();
            { ArgP ab = ap0; asm volatile("" : "+s"(ab)); xcd_barrier((unsigned*)(ab->ws + WS_BAR), (volatile LAS unsigned*)(lds + LDS_MISC)); }
        }
    }
#undef WPTR
}

#ifndef N_LAUNCH_PER_PHASE
#define N_LAUNCH_PER_PHASE 0
#endif
extern "C" void kernel_launch(void* const* d_in, const int* in_sizes, int n_in, void* d_out, int out_size, void* d_ws, size_t ws_size, hipStream_t stream) {
    static int grid = 0;
    if (grid == 0) {
        if (n_in != 27 || in_sizes[0] != TT * DM || out_size != TT * DM || ws_size < WS_END) {
            fprintf(stderr, "kernel_launch: unexpected shapes: n_in %d in0 %d out %d ws %zu (need %zu)\n", n_in, n_in > 0 ? in_sizes[0] : -1, out_size, ws_size, (size_t)WS_END);
            grid = -1; return; }
        int dev = 0, cus = 0, per_cu = 0;
        hipGetDevice(&dev); hipDeviceGetAttribute(&cus, hipDeviceAttributeMultiprocessorCount, dev);
        hipFuncSetAttribute((const void*)hybrid_fwd, hipFuncAttributeMaxDynamicSharedMemorySize, LDS_BYTES);
        hipOccupancyMaxActiveBlocksPerMultiprocessor(&per_cu, (const void*)hybrid_fwd, 512, LDS_BYTES);
        (void)hipGetLastError();
        if (per_cu < 1) { fprintf(stderr, "kernel_launch: occupancy query says %d blocks/CU\n", per_cu); }
        grid = cus > 0 ? cus : 256;
    }
    if (grid < 0) return;
    Args a{};
    for (int i = 0; i < 27; ++i) a.in[i] = (const float*)d_in[i];
    a.out = (float*)d_out; a.ws = (unsigned char*)d_ws;
#if N_LAUNCH_PER_PHASE
    for (int ph = 0; ph < N_PHASES; ++ph) {
        a.ph_lo = ph; a.ph_hi = ph + 1;
        hipLaunchKernelGGL(hybrid_fwd, dim3(grid), dim3(512), LDS_BYTES, stream, a);
    }
#else
    a.ph_lo = 0; a.ph_hi = N_PHASES;
    (void)hipMemsetAsync((char*)d_ws + WS_BAR, 0, 16384, stream);
    void* kargs[] = {&a};
    hipError_t e = hipLaunchCooperativeKernel((const void*)hybrid_fwd, dim3(grid), dim3(512), kargs, LDS_BYTES, stream);
    if (e != hipSuccess) fprintf(stderr, "cooperative launch failed: %s (grid %d)\n", hipGetErrorString(e), grid);
#endif
}
```

```cpp
#include <hip/hip_runtime.h>
#include <hip/hip_cooperative_groups.h>
#include <cstdio>
#include <cstdint>
namespace cg = cooperative_groups;

#define LAS __attribute__((address_space(3)))
typedef unsigned short bf16_t;
typedef short bf16x8 __attribute__((ext_vector_type(8)));
typedef float f32x4 __attribute__((ext_vector_type(4)));
typedef float f32x16 __attribute__((ext_vector_type(16)));
typedef unsigned u32x4 __attribute__((ext_vector_type(4)));
typedef unsigned u32x2 __attribute__((ext_vector_type(2)));

constexpr int DM = 1024, NB = 8, SEQ = 4096, TT = NB * SEQ, DFF = 2688, NLAYER = 2;
constexpr int HYW = 512, INW = 3840, QKVW = 2304, GATEW = 2048;
constexpr float EPS = 1e-6f;

constexpr size_t MiB = 1u << 20;
constexpr size_t WS_SSQ = 0;
constexpr size_t WS_HID = 2 * MiB;
constexpr size_t WS_BTAB = 4 * MiB;
constexpr size_t WS_BAR = 4 * MiB + 65536;
constexpr size_t WS_FPART = 4 * MiB + 524288;
constexpr size_t WS_W = 5 * MiB;
constexpr size_t W_UP1 = 0, W_DN1 = W_UP1 + (size_t)2 * DFF * DM * 2, W_IN = W_DN1 + (size_t)DM * DFF * 2,
                 W_HY = W_IN + (size_t)(INW + GATEW) * DM * 2, W_AT = W_HY + (size_t)DM * 512 * 2, W_OUT = W_AT + (size_t)DM * 256 * 2,
                 W_UP2 = W_OUT + (size_t)DM * DM * 2, W_DN2 = W_UP2 + (size_t)2 * DFF * DM * 2, W_END = W_DN2 + (size_t)DM * DFF * 2;
static_assert(W_END <= 47 * MiB, "weights region");
constexpr size_t WS_XB = 52 * MiB;
constexpr size_t WS_OG = WS_XB;
constexpr size_t WS_LSE = WS_XB + 48 * MiB;
constexpr size_t WS_BIG = 116 * MiB;
constexpr size_t WS_H = WS_BIG;
constexpr size_t WS_PT = WS_BIG;
constexpr size_t WS_QKV = WS_BIG + 96 * MiB;
constexpr size_t WS_G = WS_QKV + 144 * MiB;
constexpr size_t WS_YHY = WS_QKV;
constexpr size_t WS_YAT = WS_QKV + 32 * MiB;
constexpr size_t WS_Y = WS_QKV + 48 * MiB;
constexpr size_t WS_GBUF = WS_G + 128 * MiB;
constexpr size_t WS_END = WS_GBUF + 16 * MiB;

constexpr int LDS_RS = 131072, LDS_MISC = LDS_RS + 16384, LDS_BYTES = LDS_MISC + 1024;

__device__ __forceinline__ unsigned pk2(float lo, float hi) {
    typedef float f2 __attribute__((ext_vector_type(2))); typedef __bf16 b2 __attribute__((ext_vector_type(2)));
    f2 v = {lo, hi}; b2 b = __builtin_convertvector(v, b2); return __builtin_bit_cast(unsigned, b);
}
__device__ __forceinline__ float bf_lo(unsigned w) { return __uint_as_float(w << 16); }
__device__ __forceinline__ float bf_hi(unsigned w) { return __uint_as_float(w & 0xffff0000u); }
__device__ __forceinline__ float bf1(bf16_t h) { return __uint_as_float(((unsigned)h) << 16); }
__device__ __forceinline__ float shx(float v, int mask) {
    int l; asm volatile("v_mbcnt_lo_u32_b32 %0, -1, 0\n\tv_mbcnt_hi_u32_b32 %0, -1, %0" : "=v"(l));
    return __int_as_float(__builtin_amdgcn_ds_bpermute((l ^ mask) << 2, __float_as_int(v)));
}
__device__ __forceinline__ float wave_sum(float v) {
#define WS_DPP(x, ctrl, rmask) __int_as_float(__builtin_amdgcn_update_dpp(0, __float_as_int(x), ctrl, rmask, 0xF, false))
    v += WS_DPP(v, 0xB1, 0xF);
    v += WS_DPP(v, 0x4E, 0xF);
    v += WS_DPP(v, 0x141, 0xF);
    v += WS_DPP(v, 0x140, 0xF);
    v += WS_DPP(v, 0x142, 0xA);
    v += WS_DPP(v, 0x143, 0xC);
#undef WS_DPP
    return __int_as_float(__builtin_amdgcn_readlane(__float_as_int(v), 63));
}
__device__ __forceinline__ float sigmoidf_(float x) { return __builtin_amdgcn_rcpf(1.f + __builtin_amdgcn_exp2f(x * -1.4426950408889634f)); }
__device__ __forceinline__ float row_rstd_q(const float* part, int row, int fq) {
    const f32x4 a = *(const f32x4*)(part + (size_t)row * 16 + 4 * fq);
    float s = (a[0] + a[1]) + (a[2] + a[3]);
    s += shx(s, 16); s += shx(s, 32);
    return rsqrtf(s * (1.0f / 1024.0f) + 1e-6f);
}
__device__ __forceinline__ float row_rstd(const float* part, int row) {
    const f32x4* p = (const f32x4*)(part + (size_t)row * 16);
    const f32x4 a = p[0], b = p[1], c = p[2], d = p[3];
    const float s = ((a[0] + a[1]) + (a[2] + a[3])) + ((b[0] + b[1]) + (b[2] + b[3])) + ((c[0] + c[1]) + (c[2] + c[3])) + ((d[0] + d[1]) + (d[2] + d[3]));
    return rsqrtf(s * (1.0f / 1024.0f) + 1e-6f);
}

namespace pg8 {
constexpr int BM = 256, BK = 64, HALF = 128, HTB = HALF * BK * 2, STAGE_BYTES = 8 * HTB, NXCD = 8, WGM = 8;
__host__ __device__ __forceinline__ int lds_byte(int r, int c) { const int st = (r >> 4) * 2 + (c >> 5), rr = r & 15, cc = c & 31, ob = rr * 64 + cc * 2; return st * 1024 + (ob ^ (((ob >> 9) & 1) << 5)); }
__host__ __device__ __forceinline__ void stage_rc(int b, int& R, int& C) { const int st = b / 1024, sb = b % 1024, swz = sb ^ (((sb >> 9) & 1) << 5); R = (st >> 1) * 16 + swz / 64; C = (st & 1) * 32 + (swz % 64) / 2; }
__host__ __device__ __forceinline__ int perm32(int rho) { const int n = rho >> 4, i = rho & 15; return 8 * (i >> 2) + 4 * n + (i & 3); }

struct Unit { int pm, pn; };
struct Gemm { const bf16_t* A; const bf16_t* Bt; int M, N, K; };

struct StaticOrder {
    int nM, nN, nwg, G, c;
    __device__ void init(int M, int N, int G_, int c_) { nM = M / BM; nN = N / BM; nwg = nM * nN; G = G_; c = c_; }
    __device__ bool next(int i, Unit& u) const {
        const long L = (long)i * G + c; if (L >= nwg) return false;
        int wgid = (int)L; { const int q = nwg / NXCD, r = nwg % NXCD, xcd = wgid % NXCD, off = wgid / NXCD; wgid = (xcd < r ? xcd * (q + 1) : r * (q + 1) + (xcd - r) * q) + off; }
        const int nig = WGM * nN, gid = wgid / nig, fm = gid * WGM, gsz = (nM - fm) < WGM ? (nM - fm) : WGM;
        u.pm = fm + ((wgid % nig) % gsz); u.pn = (wgid % nig) / gsz; return true;
    }
    __device__ __forceinline__ void a_ready(const Unit&) const {}
    __device__ __forceinline__ void done(const Unit&) const {}
};


struct EpiFfnUp {
    static constexpr bool PERM = true;
    bf16_t* H; const float* ssq; const LAS float* rstab; int rsbase;
    __device__ __forceinline__ void operator()(const f32x4 (&acc)[2][2][4][2], const Unit& u, int wr, int wc, int fr, int fq) const {
        const int row0 = u.pm * BM + wr * 64 + fr, col0 = u.pn * 128 + wc * 32 + 8 * fq;
#pragma unroll
        for (int ai = 0; ai < 2; ++ai)
#pragma unroll
            for (int m = 0; m < 4; ++m) {
                const int row = row0 + ai * HALF + m * 16;
                const float rs = rstab ? rstab[row - rsbase] : row_rstd_q(ssq, row, fq);
                float h[8];
#pragma unroll
                for (int n = 0; n < 2; ++n)
#pragma unroll
                    for (int e = 0; e < 4; ++e) { const float g = acc[ai][0][m][n][e] * rs, up = acc[ai][1][m][n][e] * rs; h[n * 4 + e] = g * sigmoidf_(g) * up; }
                u32x4 w; w.x = pk2(h[0], h[1]); w.y = pk2(h[2], h[3]); w.z = pk2(h[4], h[5]); w.w = pk2(h[6], h[7]);
                *(u32x4*)(H + (size_t)row * DFF + col0) = w;
            }
    }
};
struct EpiResid {
    static constexpr bool PERM = false;
    const float* Xin; float* Xout; bf16_t* XB; float* ssq; float alpha;
    __device__ __forceinline__ void ldb(f32x4 (&xi)[2][2][2], int row0, int col0, int bt) const {
        const int ai = bt >> 1, mh = bt & 1;
#pragma unroll
        for (int mm = 0; mm < 2; ++mm)
#pragma unroll
            for (int bj = 0; bj < 2; ++bj)
#pragma unroll
                for (int n = 0; n < 2; ++n) xi[mm][bj][n] = *(const f32x4*)(Xin + (size_t)(row0 + ai * HALF + (2 * mh + mm) * 16) * DM + col0 + bj * HALF + n * 16);
    }
    __device__ __forceinline__ void stb(const f32x4 (&xi)[2][2][2], const f32x4 (&acc)[2][2][4][2], const Unit& u, int wc, int fq, int row0, int col0, int bt) const {
        const int ai = bt >> 1, mh = bt & 1;
#pragma unroll
        for (int mm = 0; mm < 2; ++mm) {
            const int m = 2 * mh + mm, row = row0 + ai * HALF + m * 16; float s = 0.f;
#pragma unroll
            for (int bj = 0; bj < 2; ++bj)
#pragma unroll
                for (int n = 0; n < 2; ++n) {
                    const size_t off = (size_t)row * DM + col0 + bj * HALF + n * 16;
                    const f32x4 v = xi[mm][bj][n] + acc[ai][bj][m][n] * alpha;
                    *(f32x4*)(Xout + off) = v;
                    u32x2 w; w.x = pk2(v[0], v[1]); w.y = pk2(v[2], v[3]);
                    *(u32x2*)(XB + off) = w;
                    s += (v[0] * v[0] + v[1] * v[1]) + (v[2] * v[2] + v[3] * v[3]);
                }
            if (ssq) { s += shx(s, 16); s += shx(s, 32); if (fq == 0) ssq[(size_t)row * 16 + u.pn * 4 + wc] = s; }
        }
    }
    __device__ __forceinline__ void operator()(const f32x4 (&acc)[2][2][4][2], const Unit& u, int wr, int wc, int fr, int fq) const {
        const int row0 = u.pm * BM + wr * 64 + fr, col0 = u.pn * BM + wc * 32 + 4 * fq;
        f32x4 xa[2][2][2], xb[2][2][2];
        ldb(xa, row0, col0, 0); ldb(xb, row0, col0, 1);
        asm volatile("" ::: "memory");
        stb(xa, acc, u, wc, fq, row0, col0, 0); ldb(xa, row0, col0, 2);
        asm volatile("" ::: "memory");
        stb(xb, acc, u, wc, fq, row0, col0, 1); ldb(xb, row0, col0, 3);
        asm volatile("" ::: "memory");
        stb(xa, acc, u, wc, fq, row0, col0, 2);
        asm volatile("" ::: "memory");
        stb(xb, acc, u, wc, fq, row0, col0, 3);
    }
};
struct EpiWin {
    static constexpr bool PERM = true;
    bf16_t* PT; bf16_t* QKV; bf16_t* G; const float* ssq; const float* bgate; const LAS float* rstab; int rsbase;
    __device__ __forceinline__ void operator()(const f32x4 (&acc)[2][2][4][2], const Unit& u, int wr, int wc, int fr, int fq) const {
        const int row0 = u.pm * BM + wr * 64 + fr, colt = u.pn * BM + wc * 32 + 8 * fq;
        if (u.pn < 6) {
            const bool odd = fr & 1;
#pragma unroll
            for (int ai = 0; ai < 2; ++ai)
#pragma unroll
                for (int m = 0; m < 4; ++m) {
                    const int row = row0 + ai * HALF + m * 16;
                    const float rs = rstab ? rstab[row - rsbase] : row_rstd_q(ssq, row, fq);
                    const int rowp = row & ~1;
#pragma unroll
                    for (int bj = 0; bj < 2; ++bj)
#pragma unroll
                        for (int n = 0; n < 2; ++n) {
                            const f32x4 v = acc[ai][bj][m][n] * rs;
                            const float s0 = odd ? v[0] : v[2], s1 = odd ? v[1] : v[3];
                            const float r0 = shx(s0, 1), r1 = shx(s1, 1);
                            const float k0 = odd ? v[2] : v[0], k1 = odd ? v[3] : v[1];
                            const int col = colt + bj * HALF + 4 * n + (odd ? 2 : 0);
                            const unsigned w0 = odd ? pk2(r0, k0) : pk2(k0, r0), w1 = odd ? pk2(r1, k1) : pk2(k1, r1);
                            *(unsigned*)(PT + (size_t)col * TT + rowp) = w0;
                            *(unsigned*)(PT + (size_t)(col + 1) * TT + rowp) = w1;
                        }
                }
        } else if (u.pn < 15) {
#pragma unroll
            for (int ai = 0; ai < 2; ++ai)
#pragma unroll
                for (int m = 0; m < 4; ++m) {
                    const int row = row0 + ai * HALF + m * 16;
                    const float rs = rstab ? rstab[row - rsbase] : row_rstd_q(ssq, row, fq);
#pragma unroll
                    for (int bj = 0; bj < 2; ++bj) {
                        const f32x4 v0 = acc[ai][bj][m][0] * rs, v1 = acc[ai][bj][m][1] * rs;
                        u32x4 w; w.x = pk2(v0[0], v0[1]); w.y = pk2(v0[2], v0[3]); w.z = pk2(v1[0], v1[1]); w.w = pk2(v1[2], v1[3]);
                        *(u32x4*)(QKV + (size_t)row * QKVW + (colt - 1536 + bj * HALF)) = w;
                    }
                }
        } else {
            f32x4 bv[2][2];
#pragma unroll
            for (int bj = 0; bj < 2; ++bj)
#pragma unroll
                for (int n = 0; n < 2; ++n) bv[bj][n] = *(const f32x4*)(bgate + (colt - INW + bj * HALF + 4 * n));
#pragma unroll
            for (int ai = 0; ai < 2; ++ai)
#pragma unroll
                for (int m = 0; m < 4; ++m) {
                    const int row = row0 + ai * HALF + m * 16;
                    const float rs = rstab ? rstab[row - rsbase] : row_rstd_q(ssq, row, fq);
#pragma unroll
                    for (int bj = 0; bj < 2; ++bj) {
                        const f32x4 v0 = acc[ai][bj][m][0] * rs + bv[bj][0], v1 = acc[ai][bj][m][1] * rs + bv[bj][1];
                        u32x4 w; w.x = pk2(sigmoidf_(v0[0]), sigmoidf_(v0[1])); w.y = pk2(sigmoidf_(v0[2]), sigmoidf_(v0[3]));
                        w.z = pk2(sigmoidf_(v1[0]), sigmoidf_(v1[1])); w.w = pk2(sigmoidf_(v1[2]), sigmoidf_(v1[3]));
                        *(u32x4*)(G + (size_t)row * GATEW + (colt - INW + bj * HALF)) = w;
                    }
                }
        }
    }
};
template <bool ADD> struct EpiMerge {
    static constexpr bool PERM = true;
    bf16_t* Y; const bf16_t* G; int goff;
    __device__ __forceinline__ void operator()(const f32x4 (&acc)[2][2][4][2], const Unit& u, int wr, int wc, int fr, int fq) const {
        const int row0 = u.pm * BM + wr * 64 + fr, colt = u.pn * BM + wc * 32 + 8 * fq;
#pragma unroll
        for (int ai = 0; ai < 2; ++ai)
#pragma unroll
            for (int m = 0; m < 4; ++m) {
                const int row = row0 + ai * HALF + m * 16;
#pragma unroll
                for (int bj = 0; bj < 2; ++bj) {
                    const int col = colt + bj * HALF;
                    const u32x4 gw = *(const u32x4*)(G + (size_t)row * GATEW + goff + col);
                    const f32x4 a0 = acc[ai][bj][m][0], a1 = acc[ai][bj][m][1];
                    float o[8];
                    o[0] = bf_lo(gw.x) * a0[0]; o[1] = bf_hi(gw.x) * a0[1]; o[2] = bf_lo(gw.y) * a0[2]; o[3] = bf_hi(gw.y) * a0[3];
                    o[4] = bf_lo(gw.z) * a1[0]; o[5] = bf_hi(gw.z) * a1[1]; o[6] = bf_lo(gw.w) * a1[2]; o[7] = bf_hi(gw.w) * a1[3];
                    u32x4* yp = (u32x4*)(Y + (size_t)row * DM + col);
                    if (ADD) { const u32x4 yw = *yp;
                        o[0] += bf_lo(yw.x); o[1] += bf_hi(yw.x); o[2] += bf_lo(yw.y); o[3] += bf_hi(yw.y);
                        o[4] += bf_lo(yw.z); o[5] += bf_hi(yw.z); o[6] += bf_lo(yw.w); o[7] += bf_hi(yw.w); }
                    u32x4 w; w.x = pk2(o[0], o[1]); w.y = pk2(o[2], o[3]); w.z = pk2(o[4], o[5]); w.w = pk2(o[6], o[7]);
                    *yp = w;
                }
            }
    }
};

template <class Epi, class Sched, bool ALIGN_EPI = true, bool SP2 = true>
__device__ __forceinline__ void gemm_phase(LAS unsigned char* lds, const Gemm g, const Sched& S, const Epi& E, const int tid) {
    const int wid = __builtin_amdgcn_readfirstlane(tid >> 6), lane = tid & 63, wr = wid >> 2, wc = wid & 3, fr = lane & 15, fq = lane >> 4;
    const int K = g.K, nt = K / BK;
    unsigned voffA[2], voffB[2];
#pragma unroll
    for (int i = 0; i < 2; ++i) { int R, C; stage_rc(tid * 16 + i * 8192, R, C); const int Rb = Epi::PERM ? ((R & ~31) + perm32(R & 31)) : R;
        voffA[i] = (unsigned)(R * K + C) * 2u; voffB[i] = (unsigned)(Rb * K + C) * 2u; }
    const size_t kstep = (size_t)(BK * 2);
    const size_t hstep = (size_t)HALF * K * 2;
    const size_t tstep = 2 * hstep;
    const unsigned ldsw = (unsigned)wid * 1024u;
    const int aoff = lds_byte(wr * 64 + fr, fq * 8), boff = lds_byte(wc * 32 + fr, fq * 8);
#define PG8_SA(b, h) (((b) * 2 + (h)) * HTB)
#define PG8_SB(b, h) ((4 + (b) * 2 + (h)) * HTB)
#define PG8_STAGE(bufoff, gbase, voff) do { _Pragma("unroll") for (int _i = 0; _i < 2; ++_i) \
        __builtin_amdgcn_global_load_lds((const unsigned*)((const char*)(gbase) + (voff)[_i]), (LAS unsigned*)(lds + (bufoff) + ldsw + _i * 8192), 16, 0, 0); } while (0)
#define PG8_LDA(dst, b, h) do { _Pragma("unroll") for (int m = 0; m < 4; ++m) _Pragma("unroll") for (int k = 0; k < 2; ++k) dst[m][k] = *(const LAS bf16x8*)(lds + PG8_SA(b, h) + aoff + m * 2048 + k * 1024); } while (0)
#define PG8_LDB(dst, b, h) do { _Pragma("unroll") for (int n = 0; n < 2; ++n) _Pragma("unroll") for (int k = 0; k < 2; ++k) dst[n][k] = *(const LAS bf16x8*)(lds + PG8_SB(b, h) + boff + n * 2048 + k * 1024); } while (0)
#define PG8_MMA(ai, bj, At, Bt) do { __builtin_amdgcn_s_setprio(1); _Pragma("unroll") for (int m = 0; m < 4; ++m) _Pragma("unroll") for (int n = 0; n < 2; ++n) _Pragma("unroll") for (int k = 0; k < 2; ++k) \
        acc[ai][bj][m][n] = __builtin_amdgcn_mfma_f32_16x16x32_bf16(Bt[n][k], At[m][k], acc[ai][bj][m][n], 0, 0, 0); __builtin_amdgcn_s_setprio(0); } while (0)
#define PG8_WAIT_V(n) asm volatile("s_waitcnt vmcnt(" #n ")" ::: "memory")
#define PG8_WAIT_L(n) asm volatile("s_waitcnt lgkmcnt(" #n ")" ::: "memory")
#define PG8_BAR __builtin_amdgcn_s_barrier()
#define PG8_SCHED __builtin_amdgcn_sched_barrier(0)
    Unit cur, nxt; int ui = 0;
    if (!S.next(0, cur)) return;
    f32x4 acc[2][2][4][2];
#pragma unroll
    for (int a = 0; a < 2; ++a)
#pragma unroll
        for (int b = 0; b < 2; ++b)
#pragma unroll
            for (int m = 0; m < 4; ++m)
#pragma unroll
                for (int n = 0; n < 2; ++n) acc[a][b][m][n] = (f32x4){0.f, 0.f, 0.f, 0.f};
    bf16x8 At[4][2], B0[2][2], B1[2][2];
    const char* cA = (const char*)g.A + (size_t)cur.pm * tstep; const char* cB = (const char*)g.Bt + (size_t)cur.pn * tstep;
    S.a_ready(cur);
    if constexpr (SP2) {
        PG8_STAGE(PG8_SB(0, 0), cB, voffB); PG8_STAGE(PG8_SB(0, 1), cB + hstep, voffB); PG8_STAGE(PG8_SA(0, 0), cA, voffA); PG8_STAGE(PG8_SA(0, 1), cA + hstep, voffA);
        if (wr == 1) PG8_BAR;
        PG8_WAIT_V(2); PG8_BAR;
        PG8_STAGE(PG8_SB(1, 0), cB + kstep, voffB); PG8_STAGE(PG8_SA(1, 0), cA + kstep, voffA); PG8_STAGE(PG8_SB(1, 1), cB + hstep + kstep, voffB);
        PG8_WAIT_V(6); PG8_BAR;
    } else {
        PG8_STAGE(PG8_SB(0, 0), cB, voffB); PG8_STAGE(PG8_SA(0, 0), cA, voffA); PG8_STAGE(PG8_SB(0, 1), cB + hstep, voffB); PG8_STAGE(PG8_SA(0, 1), cA + hstep, voffA);
        if (wr == 1) PG8_BAR;
        PG8_WAIT_V(4); PG8_BAR;
        PG8_STAGE(PG8_SB(1, 0), cB + kstep, voffB); PG8_STAGE(PG8_SA(1, 0), cA + kstep, voffA); PG8_STAGE(PG8_SB(1, 1), cB + hstep + kstep, voffB);
        PG8_WAIT_V(6); PG8_BAR;
    }
    for (;;) {
        const bool has_next = S.next(ui + 1, nxt);
        const char* nA = has_next ? (const char*)g.A + (size_t)nxt.pm * tstep : cA; const char* nB = has_next ? (const char*)g.Bt + (size_t)nxt.pn * tstep : cB;
        for (int t = 0; t < nt; t += 2) {
            const bool last = (t == nt - 2);
            const char* a1 = cA + (size_t)(t + 1) * kstep;
            const char* a2 = last ? nA : cA + (size_t)(t + 2) * kstep; const char* b2 = last ? nB : cB + (size_t)(t + 2) * kstep;
            const char* a3 = a2 + kstep; const char* b3 = b2 + kstep;
            if (last && has_next) S.a_ready(nxt);
            if constexpr (SP2) {
            PG8_LDB(B0, 0, 0); PG8_LDB(B1, 0, 1); PG8_SCHED; PG8_LDA(At, 0, 0); PG8_STAGE(PG8_SA(1, 1), a1 + hstep, voffA);
            PG8_WAIT_V(8); PG8_WAIT_L(0); PG8_BAR; PG8_MMA(0, 0, At, B0); PG8_MMA(0, 1, At, B1); PG8_BAR; PG8_SCHED;
            PG8_LDA(At, 0, 1); PG8_STAGE(PG8_SB(0, 0), b2, voffB); PG8_STAGE(PG8_SB(0, 1), b2 + hstep, voffB); PG8_STAGE(PG8_SA(0, 0), a2, voffA);
            PG8_WAIT_V(8); PG8_WAIT_L(0); PG8_BAR; PG8_MMA(1, 0, At, B0); PG8_MMA(1, 1, At, B1); PG8_BAR; PG8_SCHED;
            PG8_LDB(B0, 1, 0); PG8_LDB(B1, 1, 1); PG8_SCHED; PG8_LDA(At, 1, 0); PG8_STAGE(PG8_SA(0, 1), a2 + hstep, voffA);
            PG8_WAIT_V(8); PG8_WAIT_L(0); PG8_BAR; PG8_MMA(0, 0, At, B0); PG8_MMA(0, 1, At, B1); PG8_BAR; PG8_SCHED;
            PG8_LDA(At, 1, 1); PG8_STAGE(PG8_SB(1, 0), b3, voffB); PG8_STAGE(PG8_SB(1, 1), b3 + hstep, voffB); PG8_STAGE(PG8_SA(1, 0), a3, voffA);
            PG8_WAIT_V(8); PG8_WAIT_L(0); PG8_BAR; PG8_MMA(1, 0, At, B0); PG8_MMA(1, 1, At, B1); PG8_BAR; PG8_SCHED;
            } else {
            PG8_LDB(B0, 0, 0); PG8_SCHED; PG8_LDA(At, 0, 0); PG8_STAGE(PG8_SA(1, 1), a1 + hstep, voffA);
            PG8_WAIT_L(8); PG8_BAR; PG8_WAIT_L(0); PG8_MMA(0, 0, At, B0); PG8_BAR; PG8_SCHED;
            PG8_LDB(B1, 0, 1); PG8_STAGE(PG8_SB(0, 0), b2, voffB);
            PG8_BAR; PG8_WAIT_L(0); PG8_MMA(0, 1, At, B1); PG8_BAR;
            PG8_LDA(At, 0, 1); PG8_STAGE(PG8_SA(0, 0), a2, voffA);
            PG8_BAR; PG8_WAIT_L(0); PG8_MMA(1, 0, At, B0); PG8_BAR; PG8_SCHED;
            PG8_STAGE(PG8_SB(0, 1), b2 + hstep, voffB);
            PG8_WAIT_V(6); PG8_BAR; PG8_MMA(1, 1, At, B1); PG8_BAR;
            PG8_LDB(B0, 1, 0); PG8_SCHED; PG8_LDA(At, 1, 0); PG8_STAGE(PG8_SA(0, 1), a2 + hstep, voffA);
            PG8_WAIT_L(8); PG8_BAR; PG8_WAIT_L(0); PG8_MMA(0, 0, At, B0); PG8_BAR; PG8_SCHED;
            PG8_LDB(B1, 1, 1); PG8_STAGE(PG8_SB(1, 0), b3, voffB);
            PG8_BAR; PG8_WAIT_L(0); PG8_MMA(0, 1, At, B1); PG8_BAR;
            PG8_LDA(At, 1, 1); PG8_STAGE(PG8_SA(1, 0), a3, voffA);
            PG8_BAR; PG8_WAIT_L(0); PG8_MMA(1, 0, At, B0); PG8_BAR; PG8_SCHED;
            PG8_STAGE(PG8_SB(1, 1), b3 + hstep, voffB);
            PG8_WAIT_V(6); PG8_BAR; PG8_MMA(1, 1, At, B1); PG8_BAR;
            }
        }
        if constexpr (ALIGN_EPI) { if (wr == 0) PG8_BAR; }
        { int l2; asm volatile("v_mbcnt_lo_u32_b32 %0, -1, 0\n\tv_mbcnt_hi_u32_b32 %0, -1, %0" : "=v"(l2));
          E(acc, cur, wr, wc, l2 & 15, l2 >> 4);
          } S.done(cur);
        if (!has_next) break;
#pragma unroll
        for (int a = 0; a < 2; ++a)
#pragma unroll
            for (int b = 0; b < 2; ++b)
#pragma unroll
                for (int m = 0; m < 4; ++m)
#pragma unroll
                    for (int n = 0; n < 2; ++n) acc[a][b][m][n] = (f32x4){0.f, 0.f, 0.f, 0.f};
        cur = nxt; cA = nA; cB = nB; ++ui;
        if constexpr (ALIGN_EPI) { if (wr == 1) PG8_BAR; }
    }
    PG8_WAIT_V(0);
    if constexpr (!ALIGN_EPI) { if (wr == 0) PG8_BAR; }
    PG8_BAR;
#undef PG8_SA
#undef PG8_SB
#undef PG8_STAGE
#undef PG8_LDA
#undef PG8_LDB
#undef PG8_MMA
#undef PG8_WAIT_V
#undef PG8_WAIT_L
#undef PG8_BAR
#undef PG8_SCHED
}
}


template <class Sched>
__device__ __forceinline__ const LAS float* build_rstd_table(LAS unsigned char* lds, const Sched& S, const float* ssq, int tid, int& rsbase) {
    int pmin = 1 << 30, pmax = -1; pg8::Unit u;
    for (int i = 0; S.next(i, u); ++i) { pmin = u.pm < pmin ? u.pm : pmin; pmax = u.pm > pmax ? u.pm : pmax; }
    rsbase = pmin * 256;
    const int nrows = (pmax - pmin + 1) * 256;
    if (pmax < 0 || nrows > 4096) return nullptr;
    LAS float* tab = (LAS float*)(lds + LDS_RS);
    for (int r = tid; r < nrows; r += 512) tab[r] = row_rstd(ssq, rsbase + r);
    __syncthreads();
    return tab;
}

struct Args { const float* in[27]; float* out; unsigned char* ws; int ph_lo, ph_hi; };
typedef const __attribute__((address_space(4))) Args* ArgP;
enum { I_X = 0, I_RELB, I_F1N, I_F1G, I_F1U, I_F1D, I_MIXN, I_WIN, I_WGATE, I_BGATE, I_CONVW, I_CONVB, I_FW1, I_FB1, I_FW2, I_FB2, I_FW3, I_SKIP,
       I_QN, I_KN, I_WHY, I_WAT, I_WOUT, I_F2N, I_F2G, I_F2U, I_F2D };

__device__ __forceinline__ void tr_item(const float* W, int K, int N, bf16_t* WT, int dest_row0, const float* gain, LAS float* scr, int k0, int n0, int lane) {
    float v[32];
    const float* wp = W + (size_t)(k0 + (lane >> 5)) * N + n0 + (lane & 31);
#pragma unroll
    for (int i = 0; i < 32; ++i) v[i] = wp[(size_t)(2 * i) * N];
    if (gain) {
#pragma unroll
        for (int i = 0; i < 32; ++i) v[i] *= gain[k0 + 2 * i + (lane >> 5)];
    }
#pragma unroll
    for (int i = 0; i < 32; ++i) scr[(2 * i + (lane >> 5)) * 33 + (lane & 31)] = v[i];
    asm volatile("s_waitcnt lgkmcnt(0)" ::: "memory");
    const int c = lane & 7;
#pragma unroll
    for (int j = 0; j < 4; ++j) { const int n = (lane >> 3) + 8 * j; const LAS float* s = scr + (8 * c) * 33 + n;
        u32x4 o; o.x = pk2(s[0 * 33], s[1 * 33]); o.y = pk2(s[2 * 33], s[3 * 33]); o.z = pk2(s[4 * 33], s[5 * 33]); o.w = pk2(s[6 * 33], s[7 * 33]);
        *(u32x4*)(WT + (size_t)(dest_row0 + n) * K + k0 + 8 * c) = o; }
    asm volatile("s_waitcnt lgkmcnt(0)" ::: "memory");
}
__device__ __forceinline__ void tr_matrix(const float* W, int K, int N, bf16_t* WT, int row_off, int mode, const float* gain, LAS float* scr, int gw, int ngw, int lane) {
    const int nblk = N / 32, nitems = (K / 64) * nblk;
    for (int it = gw; it < nitems; it += ngw) {
        const int kb = it / nblk, nb = it % nblk, n0 = 32 * nb;
        int dr = row_off + n0;
        if (mode) dr = 256 * (n0 >> 7) + (mode == 2 ? 128 : 0) + (n0 & 127);
        tr_item(W, K, N, WT, dr, gain, scr, 64 * kb, n0, lane);
    }
}
__device__ __forceinline__ void convert_weights(ArgP a, int l, int mask, LAS unsigned char* lds, int gw, int ngw, int wave, int lane) {
    LAS float* scr = (LAS float*)(lds + wave * 16384);
    bf16_t* wb = (bf16_t*)(a->ws + WS_W);
    if (mask & 1) {
        const float* g1 = a->in[I_F1N] + (size_t)l * DM;
        tr_matrix(a->in[I_F1G] + (size_t)l * DM * DFF, DM, DFF, (bf16_t*)((char*)wb + W_UP1), 0, 1, g1, scr, gw, ngw, lane);
        tr_matrix(a->in[I_F1U] + (size_t)l * DM * DFF, DM, DFF, (bf16_t*)((char*)wb + W_UP1), 0, 2, g1, scr, gw, ngw, lane);
    }
    if (mask & 2) {
        tr_matrix(a->in[I_F1D] + (size_t)l * DFF * DM, DFF, DM, (bf16_t*)((char*)wb + W_DN1), 0, 0, nullptr, scr, gw, ngw, lane);
        const float* gm = a->in[I_MIXN] + (size_t)l * DM;
        tr_matrix(a->in[I_WIN] + (size_t)l * DM * INW, DM, INW, (bf16_t*)((char*)wb + W_IN), 0, 0, gm, scr, gw, ngw, lane);
        tr_matrix(a->in[I_WGATE] + (size_t)l * DM * GATEW, DM, GATEW, (bf16_t*)((char*)wb + W_IN), INW, 0, gm, scr, gw, ngw, lane);
    }
    if (mask & 4) {
        tr_matrix(a->in[I_WHY] + (size_t)l * 512 * DM, 512, DM, (bf16_t*)((char*)wb + W_HY), 0, 0, nullptr, scr, gw, ngw, lane);
        tr_matrix(a->in[I_WAT] + (size_t)l * 256 * DM, 256, DM, (bf16_t*)((char*)wb + W_AT), 0, 0, nullptr, scr, gw, ngw, lane);
        tr_matrix(a->in[I_WOUT] + (size_t)l * DM * DM, DM, DM, (bf16_t*)((char*)wb + W_OUT), 0, 0, nullptr, scr, gw, ngw, lane);
        const float* g2 = a->in[I_F2N] + (size_t)l * DM;
        tr_matrix(a->in[I_F2G] + (size_t)l * DM * DFF, DM, DFF, (bf16_t*)((char*)wb + W_UP2), 0, 1, g2, scr, gw, ngw, lane);
        tr_matrix(a->in[I_F2U] + (size_t)l * DM * DFF, DM, DFF, (bf16_t*)((char*)wb + W_UP2), 0, 2, g2, scr, gw, ngw, lane);
        tr_matrix(a->in[I_F2D] + (size_t)l * DFF * DM, DFF, DM, (bf16_t*)((char*)wb + W_DN2), 0, 0, nullptr, scr, gw, ngw, lane);
    }
}

__device__ __forceinline__ int t5_bucket(int rel) {
    const int ret = rel > 0 ? 16 : 0; const int n = rel < 0 ? -rel : rel;
    const float nf = (float)(n > 1 ? n : 1);
    int large = 8 + (int)(logf(nf / 8.0f) / 4.852030263919617f * 8.0f);
    large = large < 15 ? large : 15;
    return ret + (n < 8 ? n : large);
}
__device__ __forceinline__ void prologue(ArgP a, LAS unsigned char* lds, int gw, int ngw, int wave, int lane) {
    float* ssq = (float*)(a->ws + WS_SSQ);
    bf16_t* XB = (bf16_t*)(a->ws + WS_XB);
    const float* x = a->in[I_X];
    for (int m0 = gw * 4; m0 < TT; m0 += ngw * 4) {
        f32x4 v[4][4];
#pragma unroll
        for (int rr = 0; rr < 4; ++rr) { const f32x4* xr = (const f32x4*)(x + (size_t)(m0 + rr) * DM) + lane;
#pragma unroll
            for (int j = 0; j < 4; ++j) v[rr][j] = xr[64 * j]; }
#pragma unroll
        for (int rr = 0; rr < 4; ++rr) {
            float s = 0.f; u32x2* o8 = (u32x2*)(XB + (size_t)(m0 + rr) * DM) + lane;
#pragma unroll
            for (int j = 0; j < 4; ++j) { const f32x4 q = v[rr][j]; s += (q[0] * q[0] + q[1] * q[1]) + (q[2] * q[2] + q[3] * q[3]);
                u32x2 w; w.x = pk2(q[0], q[1]); w.y = pk2(q[2], q[3]); o8[64 * j] = w; }
            s = wave_sum(s); if (lane < 16) ssq[(size_t)(m0 + rr) * 16 + lane] = lane == 0 ? s : 0.f;
        }
    }
    { float* bt = (float*)(a->ws + WS_BTAB); const float* rb = a->in[I_RELB];
      for (int i = gw * 64 + lane; i < 12 * 129; i += ngw * 64) { const int hd = i / 129, ri = i % 129, g = hd >> 2; const int rel = (ri - 64) * (1 << (2 * g));
          bt[hd * 132 + ri] = rb[t5_bucket(rel) * 12 + hd]; } }
    { float* hid = (float*)(a->ws + WS_HID);
      for (int it = gw; it < NLAYER * SEQ; it += ngw) {
          const int l = it / SEQ, pos = it % SEQ;
          const float* w1 = a->in[I_FW1] + (size_t)l * 33 * 64; const float* b1 = a->in[I_FB1] + l * 64;
          const float* w2 = a->in[I_FW2] + (size_t)l * 64 * 64; const float* b2 = a->in[I_FB2] + l * 64;
          const float t = (float)pos / 4095.0f; const float w = (6.283185307179586f / 4096.0f) * (float)pos;
          float z = 0.f;
          if (lane == 0) z = t;
          else if (lane <= 16) { const float f = 1e-4f + (float)(lane - 1) * ((15.0f - 1e-4f) / 15.0f); z = cosf(f * w); }
          else if (lane <= 32) { const float f = 1e-4f + (float)(lane - 17) * ((15.0f - 1e-4f) / 15.0f); z = -sinf(f * w); }
          float h1 = b1[lane];
#pragma unroll
          for (int i = 0; i < 33; ++i) h1 += __int_as_float(__builtin_amdgcn_readlane(__float_as_int(z), i)) * w1[i * 64 + lane];
          h1 = sinf(h1);
          float h2 = b2[lane];
#pragma unroll
          for (int i = 0; i < 64; ++i) h2 += __int_as_float(__builtin_amdgcn_readlane(__float_as_int(h1), i)) * w2[i * 64 + lane];
          h2 = sinf(h2);
          hid[((size_t)l * 64 + lane) * SEQ + pos] = h2;
      } }
    convert_weights(a, 0, 1, lds, gw, ngw, wave, lane);
}

constexpr int UT_STRIDE = 8192 + 16, HY_UT = 0, HY_ZERO = 8 * UT_STRIDE, HY_F = HY_ZERO + 128, COPY_STRIDE = 16448, HY_RED = HY_F + 4 * COPY_STRIDE;
static_assert(HY_RED + 64 <= LDS_BYTES && HY_F % 8 == 0 && COPY_STRIDE % 8 == 0, "hyena LDS map");

__device__ __forceinline__ void conv8(const bf16_t* base, int n0, float w0, float w1, float w2, float bias, float (&out)[8]) {
    const u32x4 pw = *(const u32x4*)(base + n0);
    float p[10];
    { const float hv = bf1(base[n0 > 0 ? n0 - 1 : 0]); p[0] = n0 > 0 ? hv : 0.f; }
    p[1] = bf_lo(pw.x); p[2] = bf_hi(pw.x); p[3] = bf_lo(pw.y); p[4] = bf_hi(pw.y); p[5] = bf_lo(pw.z); p[6] = bf_hi(pw.z); p[7] = bf_lo(pw.w); p[8] = bf_hi(pw.w);
    { const float hv = bf1(base[(n0 + 8 < SEQ) ? n0 + 8 : n0]); p[9] = (n0 + 8 < SEQ) ? hv : 0.f; }
#pragma unroll
    for (int e = 0; e < 8; ++e) out[e] = w0 * p[e] + w1 * p[e + 1] + w2 * p[e + 2] + bias;
}


__device__ __forceinline__ void conv8_load(const bf16_t* base, int n0, u32x4& pw, unsigned short& hl, unsigned short& hr) {
    pw = *(const u32x4*)(base + n0);
    const unsigned short hl_ = base[n0 > 0 ? n0 - 1 : 0], hr_ = base[(n0 + 8 < SEQ) ? n0 + 8 : n0];
    hl = n0 > 0 ? hl_ : (unsigned short)0;
    hr = (n0 + 8 < SEQ) ? hr_ : (unsigned short)0;
}
__device__ __forceinline__ void conv8_calc(const u32x4 pw, unsigned short hl, unsigned short hr, float w0, float w1, float w2, float bias, float (&out)[8]) {
    float p[10];
    p[0] = bf1(hl);
    p[1] = bf_lo(pw.x); p[2] = bf_hi(pw.x); p[3] = bf_lo(pw.y); p[4] = bf_hi(pw.y); p[5] = bf_lo(pw.z); p[6] = bf_hi(pw.z); p[7] = bf_lo(pw.w); p[8] = bf_hi(pw.w);
    p[9] = bf1(hr);
#pragma unroll
    for (int e = 0; e < 8; ++e) out[e] = w0 * p[e] + w1 * p[e + 1] + w2 * p[e + 2] + bias;
}
#define FRESH_LANE(v) int v; asm volatile("v_mbcnt_lo_u32_b32 %0, -1, 0\n\tv_mbcnt_hi_u32_b32 %0, -1, %0" : "=v"(v))
__device__ __forceinline__ void filter_pass(LAS unsigned char* lds, ArgP a, int l, int bx, int G, int w) {
    FRESH_LANE(lane); const int tid = w * 64 + lane;
    const float* hid = (const float*)(a->ws + WS_HID) + (size_t)l * 64 * SEQ;
    const float* w3 = a->in[I_FW3] + (size_t)l * 64 * 2048;
    bf16_t* GB = (bf16_t*)(a->ws + WS_GBUF); float* FP = (float*)(a->ws + WS_FPART);
    LAS float* wT = (LAS float*)lds;
    LAS float* wsum = (LAS float*)(lds + 64 * 68 * 4);
    for (int item = bx; item < 256; item += G) {
        const int pb = item & 7, cg = item >> 3;
        __syncthreads();
#pragma unroll
        for (int i = 0; i < 8; ++i) { const int idx = tid + 512 * i, j = idx >> 6, cc = idx & 63; wT[cc * 68 + j] = w3[(size_t)j * 2048 + 64 * cg + cc]; }
        const int p = 512 * pb + tid;
        float h[64];
#pragma unroll
        for (int j = 0; j < 64; ++j) h[j] = hid[(size_t)j * SEQ + p];
        __syncthreads();
        const float t = (float)p / 4095.0f;
        const float mind = -3.0701134573253946f, maxd = -15.350567286626973f;
        for (int cc = 0; cc < 64; ++cc) {
            const LAS f32x4* wr4 = (const LAS f32x4*)(wT + cc * 68);
            float acc = 0.f;
#pragma unroll
            for (int j4 = 0; j4 < 16; ++j4) { const f32x4 wv = wr4[j4]; acc += h[4 * j4] * wv[0]; acc += h[4 * j4 + 1] * wv[1]; acc += h[4 * j4 + 2] * wv[2]; acc += h[4 * j4 + 3] * wv[3]; }
            const int col = 64 * cg + cc, c = col & 511, dir = (col >> 9) & 1, o = col >> 10;
            const float delta = fabsf(mind + (float)c * ((maxd - mind) / 511.0f));
            const float v = acc * expf(-t * delta);
            const bool skip0 = (dir == 1) && (p == 0);
            float sq = skip0 ? 0.f : v * v;
            sq = wave_sum(sq);
            if (lane == 0) wsum[w * 64 + cc] = sq;
            if (!skip0) GB[(size_t)(o * 512 + c) * 8192 + (dir ? 4096 + p : 4096 - p)] = (bf16_t)(pk2(v, 0.f) & 0xffffu);
        }
        __syncthreads();
        if (tid < 64) { float sacc = 0.f;
#pragma unroll
            for (int ww = 0; ww < 8; ++ww) sacc += wsum[ww * 64 + tid];
            FP[(size_t)(64 * cg + tid) * 8 + pb] = sacc; }
    }
    __syncthreads();
}

template <int IG0, int IG1, bool CHECK = true>
__device__ __forceinline__ void hy_seg(LAS unsigned char* lds, f32x16 (&acc)[4], int d0, int d1, int abase, int bbase, int jbase) {
    bf16x8 A0, A1, B0[4], B1[4];
    int eight_ = 8; asm volatile("" : "+v"(eight_));
#define HY_LOAD(A, B, dd, ks) do { const int aa_ = abase - 128 * (dd) + 32 * (ks); const int ab_ = aa_ + eight_; \
        const u32x2 lo_ = *(const LAS u32x2*)(lds + aa_), hi_ = *(const LAS u32x2*)(lds + ab_); u32x4 av_; av_.x = lo_.x; av_.y = lo_.y; av_.z = hi_.x; av_.w = hi_.y; A = __builtin_bit_cast(bf16x8, av_); \
        _Pragma("unroll") for (int ig = IG0; ig < IG1; ++ig) { const int jb_ = jbase + 4 * ig - (dd); const int ba_ = (!CHECK || (unsigned)jb_ < 64u) ? (bbase + jb_ * 128 + 32 * (ks)) : HY_ZERO; B[ig] = *(const LAS bf16x8*)(lds + ba_); } } while (0)
#define HY_MMA(A, B) do { __builtin_amdgcn_s_setprio(1); _Pragma("unroll") for (int ig = IG0; ig < IG1; ++ig) acc[ig] = __builtin_amdgcn_mfma_f32_32x32x16_bf16(A, B[ig], acc[ig], 0, 0, 0); __builtin_amdgcn_s_setprio(0); } while (0)
#define HY_SB ((void)0)
    HY_LOAD(A0, B0, d0, 0);
#pragma unroll 1
    for (int d = d0; d <= d1; ++d) {
        HY_LOAD(A1, B1, d, 1); HY_SB; HY_MMA(A0, B0); HY_SB;
        HY_LOAD(A0, B0, d, 2); HY_SB; HY_MMA(A1, B1); HY_SB;
        HY_LOAD(A1, B1, d, 3); HY_SB; HY_MMA(A0, B0); HY_SB;
        HY_LOAD(A0, B0, d + 1, 0); HY_SB; HY_MMA(A1, B1); HY_SB;
    }
#undef HY_LOAD
#undef HY_MMA
#undef HY_SB
}

__device__ __forceinline__ void hyena_job(LAS unsigned char* lds, ArgP a, int l, int c, int w) {
    FRESH_LANE(lane); const int tid = w * 64 + lane, hh = lane >> 5, ql = lane & 31;
    bf16_t* PT = (bf16_t*)(a->ws + WS_PT);
    const float* cw = a->in[I_CONVW] + (size_t)l * 3 * 1536; const float* cb = a->in[I_CONVB] + (size_t)l * 1536;
    const float* skip = a->in[I_SKIP] + (size_t)l * 2 * 512;
    __syncthreads();
    if (tid < 32) ((LAS unsigned*)(lds + HY_ZERO))[tid] = 0u;
    {
        const float w0 = cw[c], w1 = cw[1536 + c], w2 = cw[3072 + c], bs = cb[c];
        const int n0 = 8 * tid;
#pragma unroll
        for (int b = 0; b < NB; ++b) {
            float o[8]; conv8(PT + (size_t)c * TT + b * SEQ, n0, w0, w1, w2, bs, o);
            u32x4 ww; ww.x = pk2(o[0], o[1]); ww.y = pk2(o[2], o[3]); ww.z = pk2(o[4], o[5]); ww.w = pk2(o[6], o[7]);
            *(LAS u32x4*)(lds + HY_UT + b * UT_STRIDE + n0 * 2) = ww;
        }
    }
    const int rhalf = w & 1, Wq = w >> 1;
    for (int o = 0; o < 2; ++o) {
        float nrm;
        {
            FRESH_LANE(lane_f); const int tid = w * 64 + lane_f;
            int zoff = 0; asm volatile("" : "+v"(zoff));
            const bf16_t* gb = (const bf16_t*)(a->ws + WS_GBUF) + (size_t)(o * 512 + c) * 8192 + zoff;
            const float* fp = (const float*)(a->ws + WS_FPART) + zoff;
            unsigned short gv[16];
#pragma unroll
            for (int k = 0; k < 16; ++k) gv[k] = gb[tid + 512 * k];
            float tot = 0.f;
#pragma unroll
            for (int pb = 0; pb < 8; ++pb) tot += fp[(size_t)(o * 1024 + c) * 8 + pb];
#pragma unroll
            for (int pb = 0; pb < 8; ++pb) tot += fp[(size_t)(o * 1024 + 512 + c) * 8 + pb];
            nrm = rsqrtf(tot + EPS); asm volatile("" : "+v"(nrm));
#pragma unroll
            for (int k = 0; k < 16; ++k) { const int t = tid + 512 * k;
#pragma unroll
                for (int sft = 0; sft < 4; ++sft) if (t - sft >= 0) *(LAS bf16_t*)(lds + HY_F + sft * COPY_STRIDE + (t - sft) * 2) = gv[k]; }
        }
        __syncthreads();
        f32x16 acc[4];
#pragma unroll
        for (int ig = 0; ig < 4; ++ig)
#pragma unroll
            for (int e = 0; e < 16; ++e) acc[ig][e] = 0.f;
        {
            FRESH_LANE(lane_m); const int hh = lane_m >> 5, ql = lane_m & 31;
            const int r = 32 * rhalf + ql;
            const int sh = (4 - (r & 3)) & 3;
            const int abase = HY_F + sh * COPY_STRIDE + (4096 - r + 8 * hh - sh) * 2;
            const int il = ql >> 3, bb = ql & 7;
            const int bbase = HY_UT + bb * UT_STRIDE + (8 * hh) * 2;
            const int jbase = 16 * Wq + il, dlo = 16 * Wq - 63;
            hy_seg<0, 1>(lds, acc, dlo, dlo + 3, abase, bbase, jbase);
            hy_seg<0, 2>(lds, acc, dlo + 4, dlo + 7, abase, bbase, jbase);
            hy_seg<0, 3>(lds, acc, dlo + 8, dlo + 11, abase, bbase, jbase);
            hy_seg<0, 4>(lds, acc, dlo + 12, 16 * Wq - 49, abase, bbase, jbase);
            hy_seg<0, 4, false>(lds, acc, 16 * Wq - 48, 16 * Wq - 1, abase, bbase, jbase);
            hy_seg<0, 4>(lds, acc, 16 * Wq, 16 * Wq + 3, abase, bbase, jbase);
            hy_seg<1, 4>(lds, acc, 16 * Wq + 4, 16 * Wq + 7, abase, bbase, jbase);
            hy_seg<2, 4>(lds, acc, 16 * Wq + 8, 16 * Wq + 11, abase, bbase, jbase);
            hy_seg<3, 4>(lds, acc, 16 * Wq + 12, 16 * Wq + 15, abase, bbase, jbase);
        }
        __syncthreads();
        {
            FRESH_LANE(lane_y); const int hh = lane_y >> 5, ql = lane_y & 31, il = ql >> 3, bb = ql & 7;
            const float sk = skip[o * 512 + c];
#pragma unroll
            for (int ig = 0; ig < 4; ++ig) {
                const int i = 16 * Wq + 4 * ig + il;
#pragma unroll
                for (int q4 = 0; q4 < 4; ++q4) {
                    const int n = 64 * i + 32 * rhalf + 8 * q4 + 4 * hh;
                    LAS u32x2* up = (LAS u32x2*)(lds + HY_UT + bb * UT_STRIDE + n * 2);
                    const u32x2 uw = *up;
                    u32x2 yw; yw.x = pk2(nrm * acc[ig][4 * q4 + 0] + sk * bf_lo(uw.x), nrm * acc[ig][4 * q4 + 1] + sk * bf_hi(uw.x));
                    yw.y = pk2(nrm * acc[ig][4 * q4 + 2] + sk * bf_lo(uw.y), nrm * acc[ig][4 * q4 + 3] + sk * bf_hi(uw.y));
                    *up = yw;
                }
            }
        }
        __syncthreads();
        {
            FRESH_LANE(lane_g); const int tid = w * 64 + lane_g;
            const int gc = 512 * (o + 1) + c;
            const float w0 = cw[gc], w1 = cw[1536 + gc], w2 = cw[3072 + gc], bs = cb[gc];
            const int n0 = 8 * tid;
            u32x4 gpw[NB]; unsigned short ghl[NB], ghr[NB];
#pragma unroll
            for (int b = 0; b < NB; ++b) conv8_load(PT + (size_t)gc * TT + b * SEQ, n0, gpw[b], ghl[b], ghr[b]);
            asm volatile("" ::: "memory");
#pragma unroll
            for (int b = 0; b < NB; ++b) {
                float x[8]; conv8_calc(gpw[b], ghl[b], ghr[b], w0, w1, w2, bs, x);
                LAS u32x4* yp = (LAS u32x4*)(lds + HY_UT + b * UT_STRIDE + n0 * 2);
                const u32x4 yw = *yp;
                u32x4 zw; zw.x = pk2(x[0] * bf_lo(yw.x), x[1] * bf_hi(yw.x)); zw.y = pk2(x[2] * bf_lo(yw.y), x[3] * bf_hi(yw.y));
                zw.z = pk2(x[4] * bf_lo(yw.z), x[5] * bf_hi(yw.z)); zw.w = pk2(x[6] * bf_lo(yw.w), x[7] * bf_hi(yw.w));
                if (o == 0) *yp = zw; else *(u32x4*)(PT + (size_t)c * TT + b * SEQ + n0) = zw;
            }
        }
        __syncthreads();
    }
}

constexpr int AT_K = 0, AT_KROW = 144, AT_VT = 384 * AT_KROW, AT_VROW = 392 * 2, AT_BT = AT_VT + 64 * AT_VROW;
static_assert(AT_BT + 132 * 4 <= LDS_BYTES, "attention LDS map");

__device__ __forceinline__ void attn_unit(LAS unsigned char* lds, ArgP a, int l, int u, int w) {
    FRESH_LANE(lane); const int tid = w * 64 + lane, hh = lane >> 5, ql = lane & 31;
    const bf16_t* QKV = (const bf16_t*)(a->ws + WS_QKV);
    bf16_t* OG = (bf16_t*)(a->ws + WS_OG); float* LSE = (float*)(a->ws + WS_LSE);
    const float* btab = (const float*)(a->ws + WS_BTAB);
    const float* qn = a->in[I_QN] + l * 64; const float* kn = a->in[I_KN] + l * 64;
    const int g = u >> 9, v = u & 511, b = v >> 6, rem = v & 63;
    const int dsh = 2 * g, m = SEQ >> dsh, nQb = m >> 8;
    const int Qb = rem % nQb, h = (rem / nQb) & 3, rho = rem / (4 * nQb);
    const int kidx0 = 256 * Qb - 64;
    const int q0 = 32 * w;
    const int qidx = 256 * Qb + q0 + ql;
    const size_t qrow = (size_t)b * SEQ + rho + ((size_t)qidx << dsh);
    u32x4 qw[4];
    { const bf16_t* qp = QKV + qrow * QKVW + g * 256 + h * 64 + 8 * hh;
#pragma unroll
      for (int ks = 0; ks < 4; ++ks) qw[ks] = *(const u32x4*)(qp + 16 * ks); }
    __syncthreads();
    {
        if (tid < 384) {
            const int kl = tid; const int idx = kidx0 + kl; const bool ok = idx >= 0 && idx < m;
            const size_t row = (size_t)b * SEQ + rho + ((size_t)(ok ? idx : 0) << dsh);
            const bf16_t* rp = QKV + row * QKVW + g * 256 + h * 64;
            u32x4 kw[8], vw[8];
#pragma unroll
            for (int c8 = 0; c8 < 8; ++c8) { kw[c8] = *(const u32x4*)(rp + 768 + 8 * c8); vw[c8] = *(const u32x4*)(rp + 1536 + 8 * c8); }
            if (!ok) {
#pragma unroll
                for (int c8 = 0; c8 < 8; ++c8) { kw[c8] = (u32x4){0u, 0u, 0u, 0u}; vw[c8] = (u32x4){0u, 0u, 0u, 0u}; }
            }
            float s = 0.f;
#pragma unroll
            for (int c8 = 0; c8 < 8; ++c8) {
                const float f[8] = {bf_lo(kw[c8].x), bf_hi(kw[c8].x), bf_lo(kw[c8].y), bf_hi(kw[c8].y), bf_lo(kw[c8].z), bf_hi(kw[c8].z), bf_lo(kw[c8].w), bf_hi(kw[c8].w)};
#pragma unroll
                for (int e = 0; e < 8; ++e) s += f[e] * f[e];
            }
            const float rs = rsqrtf(s * (1.0f / 64.0f) + EPS);
#pragma unroll
            for (int c8 = 0; c8 < 8; ++c8) {
                const float f[8] = {bf_lo(kw[c8].x), bf_hi(kw[c8].x), bf_lo(kw[c8].y), bf_hi(kw[c8].y), bf_lo(kw[c8].z), bf_hi(kw[c8].z), bf_lo(kw[c8].w), bf_hi(kw[c8].w)};
                const float* kg = kn + 8 * c8;
                u32x4 ko; ko.x = pk2(f[0] * rs * kg[0], f[1] * rs * kg[1]); ko.y = pk2(f[2] * rs * kg[2], f[3] * rs * kg[3]);
                ko.z = pk2(f[4] * rs * kg[4], f[5] * rs * kg[5]); ko.w = pk2(f[6] * rs * kg[6], f[7] * rs * kg[7]);
                *(LAS u32x4*)(lds + AT_K + kl * AT_KROW + 16 * c8) = ko;
                LAS bf16_t* vt = (LAS bf16_t*)(lds + AT_VT + (8 * c8) * AT_VROW + kl * 2);
                vt[0 * (AT_VROW / 2)] = (bf16_t)(vw[c8].x & 0xffffu); vt[1 * (AT_VROW / 2)] = (bf16_t)(vw[c8].x >> 16);
                vt[2 * (AT_VROW / 2)] = (bf16_t)(vw[c8].y & 0xffffu); vt[3 * (AT_VROW / 2)] = (bf16_t)(vw[c8].y >> 16);
                vt[4 * (AT_VROW / 2)] = (bf16_t)(vw[c8].z & 0xffffu); vt[5 * (AT_VROW / 2)] = (bf16_t)(vw[c8].z >> 16);
                vt[6 * (AT_VROW / 2)] = (bf16_t)(vw[c8].w & 0xffffu); vt[7 * (AT_VROW / 2)] = (bf16_t)(vw[c8].w >> 16);
            }
        } else if (tid < 384 + 129) {
            ((LAS float*)(lds + AT_BT))[tid - 384] = btab[(g * 4 + h) * 132 + (tid - 384)];
        }
    }
    __syncthreads();
    bf16x8 qf[4];
    {
        float s = 0.f;
#pragma unroll
        for (int ks = 0; ks < 4; ++ks) {
            const float f[8] = {bf_lo(qw[ks].x), bf_hi(qw[ks].x), bf_lo(qw[ks].y), bf_hi(qw[ks].y), bf_lo(qw[ks].z), bf_hi(qw[ks].z), bf_lo(qw[ks].w), bf_hi(qw[ks].w)};
#pragma unroll
            for (int e = 0; e < 8; ++e) s += f[e] * f[e]; }
        s += shx(s, 32);
        const float rs = rsqrtf(s * (1.0f / 64.0f) + EPS);
#pragma unroll
        for (int ks = 0; ks < 4; ++ks) {
            const float* gp = qn + 16 * ks + 8 * hh;
            const float f[8] = {bf_lo(qw[ks].x), bf_hi(qw[ks].x), bf_lo(qw[ks].y), bf_hi(qw[ks].y), bf_lo(qw[ks].z), bf_hi(qw[ks].z), bf_lo(qw[ks].w), bf_hi(qw[ks].w)};
            u32x4 o; o.x = pk2(f[0] * rs * gp[0], f[1] * rs * gp[1]); o.y = pk2(f[2] * rs * gp[2], f[3] * rs * gp[3]);
            o.z = pk2(f[4] * rs * gp[4], f[5] * rs * gp[5]); o.w = pk2(f[6] * rs * gp[6], f[7] * rs * gp[7]);
            qf[ks] = __builtin_bit_cast(bf16x8, o);
        }
    }
    f32x16 st[5];
#pragma unroll
    for (int kt = 0; kt < 5; ++kt) {
#pragma unroll
        for (int e = 0; e < 16; ++e) st[kt][e] = 0.f;
#pragma unroll
        for (int ks = 0; ks < 4; ++ks) {
            const bf16x8 kfr = *(const LAS bf16x8*)(lds + AT_K + (q0 + 32 * kt + ql) * AT_KROW + (16 * ks + 8 * hh) * 2);
            st[kt] = __builtin_amdgcn_mfma_f32_32x32x16_bf16(kfr, qf[ks], st[kt], 0, 0, 0);
        }
    }
    const LAS float* bt = (const LAS float*)(lds + AT_BT);
    float mx = -1e30f;
#pragma unroll
    for (int kt = 0; kt < 5; ++kt) {
        float bv[16];
#pragma unroll
        for (int e = 0; e < 16; ++e) {
            const int cr = (e & 3) + 8 * (e >> 2) + 4 * hh;
            int ri = 32 * kt + cr - ql; ri = ri < 0 ? 0 : (ri > 128 ? 128 : ri);
            bv[e] = bt[ri];
        }
#pragma unroll
        for (int e = 0; e < 16; ++e) {
            const int cr = (e & 3) + 8 * (e >> 2) + 4 * hh;
            const int rel = 32 * kt + cr - 64 - ql;
            const int kidx = kidx0 + q0 + 32 * kt + cr;
            const bool ok = rel >= -64 && rel <= 64 && kidx >= 0 && kidx < m;
            const float sv = st[kt][e] * 0.125f + bv[e];
            const float s = ok ? sv : -1e30f;
            st[kt][e] = s; mx = fmaxf(mx, s);
        }
    }
    mx = fmaxf(mx, shx(mx, 32));
    float den = 0.f;
#pragma unroll
    for (int kt = 0; kt < 5; ++kt)
#pragma unroll
        for (int e = 0; e < 16; ++e) { const float p = st[kt][e] > -1e29f ? __expf(st[kt][e] - mx) : 0.f; st[kt][e] = p; den += p; }
    den += shx(den, 32);
    f32x16 ot[2];
#pragma unroll
    for (int dt = 0; dt < 2; ++dt)
#pragma unroll
        for (int e = 0; e < 16; ++e) ot[dt][e] = 0.f;
#pragma unroll
    for (int kt = 0; kt < 5; ++kt)
#pragma unroll
        for (int s2 = 0; s2 < 2; ++s2) {
            u32x4 pw; pw.x = pk2(st[kt][8 * s2 + 0], st[kt][8 * s2 + 1]); pw.y = pk2(st[kt][8 * s2 + 2], st[kt][8 * s2 + 3]);
            pw.z = pk2(st[kt][8 * s2 + 4], st[kt][8 * s2 + 5]); pw.w = pk2(st[kt][8 * s2 + 6], st[kt][8 * s2 + 7]);
            const bf16x8 pb = __builtin_bit_cast(bf16x8, pw);
#pragma unroll
            for (int dt = 0; dt < 2; ++dt) {
                const int va = AT_VT + (32 * dt + ql) * AT_VROW + (q0 + 32 * kt + 16 * s2 + 4 * hh) * 2;
                const u32x2 lo = *(const LAS u32x2*)(lds + va), hi = *(const LAS u32x2*)(lds + va + 16);
                u32x4 av; av.x = lo.x; av.y = lo.y; av.z = hi.x; av.w = hi.y;
                ot[dt] = __builtin_amdgcn_mfma_f32_32x32x16_bf16(__builtin_bit_cast(bf16x8, av), pb, ot[dt], 0, 0, 0);
            }
        }
    const float inv = 1.0f / den;
    bf16_t* op = OG + ((size_t)g * TT + qrow) * 256 + h * 64;
#pragma unroll
    for (int dt = 0; dt < 2; ++dt)
#pragma unroll
        for (int q4 = 0; q4 < 4; ++q4) {
            u32x2 ow; ow.x = pk2(ot[dt][4 * q4 + 0] * inv, ot[dt][4 * q4 + 1] * inv); ow.y = pk2(ot[dt][4 * q4 + 2] * inv, ot[dt][4 * q4 + 3] * inv);
            *(u32x2*)(op + 32 * dt + 8 * q4 + 4 * hh) = ow;
        }
    if (hh == 0) LSE[((size_t)g * TT + qrow) * 4 + h] = mx + __logf(den);
}

__device__ __forceinline__ void trans_combine(LAS unsigned char* lds, ArgP a, int tid, int bx, int G) {
    const bf16_t* PT = (const bf16_t*)(a->ws + WS_PT); bf16_t* YHY = (bf16_t*)(a->ws + WS_YHY);
    const bf16_t* __restrict__ OG = (const bf16_t*)(a->ws + WS_OG); const float* __restrict__ LSE = (const float*)(a->ws + WS_LSE); bf16_t* __restrict__ YAT = (bf16_t*)(a->ws + WS_YAT);
    constexpr int TROW = 72 * 2;
    {
        const int lane = tid & 63, wv = tid >> 6;
        LAS unsigned char* tl = lds + wv * (64 * TROW);
        for (int tile = bx * 8 + wv; tile < 8 * 512; tile += G * 8) {
            const int cb = tile & 7, tb = tile >> 3, c8 = lane & 7;
            u32x4 v[8];
#pragma unroll
            for (int it = 0; it < 8; ++it) { const int ch = (lane >> 3) + 8 * it; v[it] = *(const u32x4*)(PT + (size_t)(64 * cb + ch) * TT + 64 * tb + 8 * c8); }
#pragma unroll
            for (int it = 0; it < 8; ++it) { const int ch = (lane >> 3) + 8 * it; *(LAS u32x4*)(tl + ch * TROW + 16 * c8) = v[it]; }
#pragma unroll
            for (int it = 0; it < 8; ++it) { const int tok = (lane >> 3) + 8 * it;
                const LAS bf16_t* sp = (const LAS bf16_t*)(tl + (8 * c8) * TROW + tok * 2);
                unsigned e[8];
#pragma unroll
                for (int k = 0; k < 8; ++k) e[k] = sp[k * (TROW / 2)];
                u32x4 o; o.x = e[0] | (e[1] << 16); o.y = e[2] | (e[3] << 16); o.z = e[4] | (e[5] << 16); o.w = e[6] | (e[7] << 16);
                *(u32x4*)(YHY + (size_t)(64 * tb + tok) * 512 + 64 * cb + 8 * c8) = o; }
        }
    }
#pragma unroll 4
    for (size_t i = (size_t)bx * 512 + tid; i < (size_t)TT * 32; i += (size_t)G * 512) {
        const size_t row = i >> 5; const int c8 = (int)(i & 31), h = c8 >> 3;
        const float l0 = LSE[(0 * (size_t)TT + row) * 4 + h], l1 = LSE[(1 * (size_t)TT + row) * 4 + h], l2 = LSE[(2 * (size_t)TT + row) * 4 + h];
        const float mxl = fmaxf(l0, fmaxf(l1, l2));
        float e0 = __expf(l0 - mxl), e1 = __expf(l1 - mxl), e2 = __expf(l2 - mxl);
        const float inv = 1.0f / (e0 + e1 + e2); e0 *= inv; e1 *= inv; e2 *= inv;
        const u32x4 a0 = *(const u32x4*)(OG + (0 * (size_t)TT + row) * 256 + 8 * c8), a1 = *(const u32x4*)(OG + (1 * (size_t)TT + row) * 256 + 8 * c8),
                    a2 = *(const u32x4*)(OG + (2 * (size_t)TT + row) * 256 + 8 * c8);
        u32x4 o;
        o.x = pk2(e0 * bf_lo(a0.x) + e1 * bf_lo(a1.x) + e2 * bf_lo(a2.x), e0 * bf_hi(a0.x) + e1 * bf_hi(a1.x) + e2 * bf_hi(a2.x));
        o.y = pk2(e0 * bf_lo(a0.y) + e1 * bf_lo(a1.y) + e2 * bf_lo(a2.y), e0 * bf_hi(a0.y) + e1 * bf_hi(a1.y) + e2 * bf_hi(a2.y));
        o.z = pk2(e0 * bf_lo(a0.z) + e1 * bf_lo(a1.z) + e2 * bf_lo(a2.z), e0 * bf_hi(a0.z) + e1 * bf_hi(a1.z) + e2 * bf_hi(a2.z));
        o.w = pk2(e0 * bf_lo(a0.w) + e1 * bf_lo(a1.w) + e2 * bf_lo(a2.w), e0 * bf_hi(a0.w) + e1 * bf_hi(a1.w) + e2 * bf_hi(a2.w));
        *(u32x4*)(YAT + row * 256 + 8 * c8) = o;
    }
}


#define XB_TMO      128
#define XB_XCNT(j)  (256  + 64 * (j))
#define XB_XSUB(j)  (1280 + 64 * (j))
#define XB_XGEN(j)  (2304 + 64 * (j))
#define XB_TOP      3328
#define XB_TOPGEN   3392
#define XCD_BAR_WORDS 3456
#define XB_SPIN_CAP (1u << 22)
__device__ __forceinline__ unsigned xb_ld(unsigned* p)              { return __hip_atomic_load(p, __ATOMIC_RELAXED, __HIP_MEMORY_SCOPE_AGENT); }
__device__ __forceinline__ unsigned xb_add(unsigned* p, unsigned v) { return __hip_atomic_fetch_add(p, v, __ATOMIC_RELAXED, __HIP_MEMORY_SCOPE_AGENT); }
__device__ __forceinline__ unsigned xb_xcc_id() { return (unsigned)__builtin_amdgcn_s_getreg((3 << 11) | 20) & 0xFu; }
#define XB_SPIN(cond, bar) do { unsigned _sp = 0; while (cond) { __builtin_amdgcn_s_sleep(1); \
    if ((++_sp & 255u) == 0u) { if (xb_ld(&(bar)[XB_TMO])) break; if (_sp > XB_SPIN_CAP) { atomicAdd(&(bar)[XB_TMO], 1u); break; } } } } while (0)
__device__ __forceinline__ void xcd_barrier_complete(unsigned* bar, unsigned x, unsigned& nloc, unsigned& nx) {
    const unsigned G = gridDim.x * gridDim.y * gridDim.z;
    unsigned sum, cnt, mine, sp = 0u;
    for (;;) {
        sum = 0u; cnt = 0u; mine = 0u;
#pragma unroll
        for (unsigned j = 0; j < 16; ++j) { const unsigned c = xb_ld(&bar[XB_XCNT(j)]); sum += c; cnt += (c > 0u) ? 1u : 0u; mine = (j == x) ? c : mine; }
        if (sum == G) break;
        __builtin_amdgcn_s_sleep(1);
        if ((++sp & 255u) == 0u) { if (xb_ld(&bar[XB_TMO])) break; if (sp > XB_SPIN_CAP) { atomicAdd(&bar[XB_TMO], 1u); break; } }
    }
    nloc = mine > 0u ? mine : 1u; nx = cnt > 0u ? cnt : 1u;
}
__device__ __forceinline__ void xcd_barrier(unsigned* bar, volatile LAS unsigned* st) {
    asm volatile("s_waitcnt vmcnt(0)" ::: "memory");
    __syncthreads();
    if (threadIdx.x == 0) {
        __builtin_amdgcn_s_waitcnt(0);
        const unsigned x = xb_xcc_id();
        unsigned nloc = st[0], nx = st[1];
        if (nloc == 0u) { xcd_barrier_complete(bar, x, nloc, nx); st[0] = nloc; st[1] = nx; }
        const unsigned old = xb_add(&bar[XB_XSUB(x)], 1u);
        const unsigned gen = old / nloc;
        if (old + 1u == (gen + 1u) * nloc) {
            __builtin_amdgcn_fence(__ATOMIC_RELEASE, "agent");
            asm volatile("s_waitcnt vmcnt(0)" ::: "memory");
            const unsigned og = xb_add(&bar[XB_TOP], 1u);
            const unsigned tg = og / nx;
            if (og + 1u == (tg + 1u) * nx) xb_add(&bar[XB_TOPGEN], 1u);
            else XB_SPIN(xb_ld(&bar[XB_TOPGEN]) == tg, bar);
            __builtin_amdgcn_fence(__ATOMIC_ACQUIRE, "agent");
            xb_add(&bar[XB_XGEN(x)], 1u);
            asm volatile("s_waitcnt vmcnt(0)" ::: "memory");
        } else {
            XB_SPIN(xb_ld(&bar[XB_XGEN(x)]) == gen, bar);
            __builtin_amdgcn_fence(__ATOMIC_ACQUIRE, "agent");
            asm volatile("s_waitcnt vmcnt(0)" ::: "memory");
        }
    }
    __syncthreads();
}

constexpr int N_PHASES = 1 + 9 * NLAYER;
#define PHASE_IDS \
    int lane; asm volatile("v_mbcnt_lo_u32_b32 %0, -1, 0\n\tv_mbcnt_hi_u32_b32 %0, -1, %0" : "=v"(lane)); \
    int G = gridDim.x, bx = blockIdx.x, wave = wave0; asm volatile("" : "+s"(G), "+s"(bx), "+s"(wave)); \
    const int tid = wave * 64 + lane; const int gw = bx * 8 + wave, ngw = G * 8; (void)gw; (void)ngw; (void)tid;
__global__ void __launch_bounds__(512, 2) hybrid_fwd(Args args_unused) {
    extern __shared__ __attribute__((aligned(16))) unsigned char lds_raw[];
    LAS unsigned char* lds = (LAS unsigned char*)lds_raw;
    cg::grid_group grid = cg::this_grid();
    const int wave0 = __builtin_amdgcn_readfirstlane(threadIdx.x >> 6);
    ArgP ap0 = (ArgP)__builtin_amdgcn_kernarg_segment_ptr();
    const int ph_lo = ap0->ph_lo, ph_hi = ap0->ph_hi;
    if (threadIdx.x < 16) ((LAS unsigned*)(lds + LDS_MISC))[threadIdx.x] = 0u;
    if (threadIdx.x == 0 && ph_hi - ph_lo > 1) (void)xb_add((unsigned*)(ap0->ws + WS_BAR) + XB_XCNT(xb_xcc_id()), 1u);
    __syncthreads();
#define WPTR(off) ((const bf16_t*)((const char*)Wb + (off)))
    for (int ph = ph_lo; ph < ph_hi; ++ph) {
        ArgP args = ap0; asm volatile("" : "+s"(args));
        unsigned char* ws = args->ws;
        float* ssq = (float*)(ws + WS_SSQ);
        bf16_t* XB = (bf16_t*)(ws + WS_XB);
        bf16_t* Hb = (bf16_t*)(ws + WS_H);
        const bf16_t* Wb = (const bf16_t*)(ws + WS_W);
        if (ph == 0) {
            PHASE_IDS
            prologue(args, lds, gw, ngw, wave, lane);
        } else {
            const int l = (ph - 1) / 9, k = (ph - 1) % 9;
            if (k == 0 || k == 7) {
                PHASE_IDS
                const int which = (k == 7);
                pg8::Gemm g{XB, WPTR(which ? W_UP2 : W_UP1), TT, 2 * DFF, DM};
                pg8::StaticOrder S; S.init(TT, 2 * DFF, G, bx);
                int rsbase = 0; const LAS float* rstab = build_rstd_table(lds, S, ssq, tid, rsbase);
                pg8::EpiFfnUp E{Hb, ssq, rstab, rsbase};
                pg8::gemm_phase<pg8::EpiFfnUp, pg8::StaticOrder>(lds, g, S, E, tid);
                {
                    const int nu = (TT / 256) * (2 * DFF / 256), rem = nu % G;
                    const int cl = (k == 0) ? l : 1;
                    const int cmask = (k == 0) ? (l == 0 ? (2 | 4) : 4) : (l == 0 ? (1 | 2) : 0);
                    if (cmask) {
                        if (rem == 0) convert_weights(args, cl, cmask, lds, gw, ngw, wave, lane);
                        else if (bx >= rem) convert_weights(args, cl, cmask, lds, (bx - rem) * 8 + wave, (G - rem) * 8, wave, lane);
                    }
                }
            } else if (k == 1 || k == 8 || k == 6) {
                PHASE_IDS
                if (k == 1) filter_pass(lds, args, l, bx, G, wave);
                const bool isout = (k == 6);
                pg8::Gemm g{isout ? (const bf16_t*)(ws + WS_Y) : Hb, WPTR(k == 1 ? W_DN1 : (k == 8 ? W_DN2 : W_OUT)), TT, DM, isout ? DM : DFF};
                pg8::StaticOrder S; S.init(TT, DM, G, bx);
                const float* xin = (l == 0 && k == 1) ? args->in[I_X] : args->out;
                const bool lastp = (l == NLAYER - 1 && k == 8);
                pg8::EpiResid E{xin, args->out, XB, lastp ? nullptr : ssq, isout ? 1.0f : 0.5f};
                pg8::gemm_phase<pg8::EpiResid, pg8::StaticOrder>(lds, g, S, E, tid);
            } else if (k == 2) {
                PHASE_IDS
                pg8::Gemm g{XB, WPTR(W_IN), TT, INW + GATEW, DM};
                pg8::StaticOrder S; S.init(TT, INW + GATEW, G, bx);
                int rsbase = 0; const LAS float* rstab = build_rstd_table(lds, S, ssq, tid, rsbase);
                pg8::EpiWin E{(bf16_t*)(ws + WS_PT), (bf16_t*)(ws + WS_QKV), (bf16_t*)(ws + WS_G), ssq, args->in[I_BGATE] + (size_t)l * GATEW, rstab, rsbase};
                pg8::gemm_phase<pg8::EpiWin, pg8::StaticOrder>(lds, g, S, E, tid);
            } else if (k == 3) {
                PHASE_IDS
                #ifndef NO_HY
                for (int c = bx; c < HYW; c += G) hyena_job(lds, args, l, c, wave);
#endif
                #ifndef NO_AT
                for (int u = bx; u < 1536; u += G) attn_unit(lds, args, l, u, wave);
#endif
            } else if (k == 4) {
                PHASE_IDS
                trans_combine(lds, args, tid, bx, G);
                __syncthreads();

            } else if (k == 5) {
                PHASE_IDS
                pg8::StaticOrder S; S.init(TT, DM, G, bx);
                { pg8::Gemm g{(const bf16_t*)(ws + WS_YHY), WPTR(W_HY), TT, DM, 512};
                  pg8::EpiMerge<false> E{(bf16_t*)(ws + WS_Y), (const bf16_t*)(ws + WS_G), 0};
                  pg8::gemm_phase<pg8::EpiMerge<false>, pg8::StaticOrder>(lds, g, S, E, tid); }
                { pg8::Gemm g{(const bf16_t*)(ws + WS_YAT), WPTR(W_AT), TT, DM, 256};
                  pg8::EpiMerge<true> E{(bf16_t*)(ws + WS_Y), (const bf16_t*)(ws + WS_G), DM};
                  pg8::gemm_phase<pg8::EpiMerge<true>, pg8::StaticOrder>(lds, g, S, E, tid); }
            }
        }
        if (ph + 1 < ph_hi) {
            if (ph_hi > 1000000) grid.sync();
            { ArgP ab = ap0; asm volatile("" : "+s"(ab)); xcd_barrier((unsigned*)(ab->ws + WS_BAR), (volatile LAS unsigned*)(lds + LDS_MISC)); }
        }
    }
#undef WPTR
}

#ifndef N_LAUNCH_PER_PHASE
#define N_LAUNCH_PER_PHASE 0
#endif
extern "C" void kernel_launch(void* const* d_in, const int* in_sizes, int n_in, void* d_out, int out_size, void* d_ws, size_t ws_size, hipStream_t stream) {
    static int grid = 0;
    if (grid == 0) {
        if (n_in != 27 || in_sizes[0] != TT * DM || out_size != TT * DM || ws_size < WS_END) {
            fprintf(stderr, "kernel_launch: unexpected shapes: n_in %d in0 %d out %d ws %zu (need %zu)\n", n_in, n_in > 0 ? in_sizes[0] : -1, out_size, ws_size, (size_t)WS_END);
            grid = -1; return; }
        int dev = 0, cus = 0, per_cu = 0;
        hipGetDevice(&dev); hipDeviceGetAttribute(&cus, hipDeviceAttributeMultiprocessorCount, dev);
        hipFuncSetAttribute((const void*)hybrid_fwd, hipFuncAttributeMaxDynamicSharedMemorySize, LDS_BYTES);
        hipOccupancyMaxActiveBlocksPerMultiprocessor(&per_cu, (const void*)hybrid_fwd, 512, LDS_BYTES);
        (void)hipGetLastError();
        if (per_cu < 1) { fprintf(stderr, "kernel_launch: occupancy query says %d blocks/CU\n", per_cu); }
        grid = cus > 0 ? cus : 256;
    }
    if (grid < 0) return;
    Args a{};
    for (int i = 0; i < 27; ++i) a.in[i] = (const float*)d_in[i];
    a.out = (float*)d_out; a.ws = (unsigned char*)d_ws;
#if N_LAUNCH_PER_PHASE
    for (int ph = 0; ph < N_PHASES; ++ph) {
        a.ph_lo = ph; a.ph_hi = ph + 1;
        hipLaunchKernelGGL(hybrid_fwd, dim3(grid), dim3(512), LDS_BYTES, stream, a);
    }
#else
    a.ph_lo = 0; a.ph_hi = N_PHASES;
    (void)hipMemsetAsync((char*)d_ws + WS_BAR, 0, 16384, stream);
    void* kargs[] = {&a};
    hipError_t e = hipLaunchCooperativeKernel((const void*)hybrid_fwd, dim3(grid), dim3(512), kargs, LDS_BYTES, stream);
    if (e != hipSuccess) fprintf(stderr, "cooperative launch failed: %s (grid %d)\n", hipGetErrorString(e), grid);
#endif
}
```
